# Optimizing an MI355X kernel written in HIP

```python
import math
import jax, jax.numpy as jnp
from jax import lax
import numpy as np

D_MODEL = 2048
BATCH = 8
SEQ = 2048
DEPTH = 2

D_MIX = D_MODEL
A_HEADS = 4
A_HEAD_DIM = 128
A_QK_HALF = A_HEAD_DIM // 2
D_A = A_HEADS * A_HEAD_DIM
B_HEADS = 8
B_HEAD_DIM = 128
D_B = B_HEADS * B_HEAD_DIM
DILATED_PATTERNS = ((128, 1), (512, 4), (2048, 16))
D_C = D_MIX - D_A - D_B
CONV_WIDTH = 31

BLOCK = 128
N_BUCKETS = 32
MAX_DISTANCE = 2048
N_ATTN_HEADS = A_HEADS + B_HEADS
ALPHA = (2 * DEPTH) ** 0.25
BETA = (8 * DEPTH) ** -0.25
EPS = 1e-5

IN_SIZES = (D_A, D_A, D_A, D_A,
            D_B, D_B, D_B, D_B,
            D_C, D_C, D_C)
D_IN = sum(IN_SIZES)
IN_OFFSETS = [int(o) for o in np.cumsum(IN_SIZES)[:-1]]

kernel_name = "hymba_diff_dilated_conformer_deepnorm"


def layer_norm(x, g, b):
    x32 = x.astype(jnp.float32)
    mu = jnp.mean(x32, axis=-1, keepdims=True)
    var = jnp.mean(jnp.square(x32 - mu), axis=-1, keepdims=True)
    y = (x32 - mu) * lax.rsqrt(var + EPS) * g.astype(jnp.float32) + b.astype(jnp.float32)
    return y.astype(x.dtype)


def t5_bucket(dist):
    max_exact = N_BUCKETS // 2
    d = jnp.maximum(dist, 0)
    df = jnp.maximum(d, 1).astype(jnp.float32)
    large = max_exact + (jnp.log(df / max_exact) / math.log(MAX_DISTANCE / max_exact)
                         * (N_BUCKETS - max_exact)).astype(jnp.int32)
    large = jnp.minimum(large, N_BUCKETS - 1)
    return jnp.where(d < max_exact, d, large)


def diff_attention(q, k, v, bias_dist, lam, lam_init, head_gain):
    B, S, H, _, Dq = q.shape
    nb = S // BLOCK
    scale = Dq ** -0.5
    qb = jnp.moveaxis(q.reshape(B, nb, BLOCK, H, 2, Dq), 1, 0)
    k_pos = jnp.arange(S)

    def one_block(args):
        qi, i = args
        q_pos = i * BLOCK + jnp.arange(BLOCK)
        dist = q_pos[:, None] - k_pos[None, :]
        bias = bias_dist[jnp.clip(dist, 0, S - 1)].astype(jnp.float32)
        s = jnp.einsum('bqhcd,bkhcd->bhcqk', qi, k).astype(jnp.float32) * scale
        s = s + jnp.transpose(bias, (2, 0, 1))[None, :, None]
        s = jnp.where(dist >= 0, s, -jnp.inf)
        p = jax.nn.softmax(s, axis=-1)
        a = p[:, :, 0] - lam * p[:, :, 1]
        return jnp.einsum('bhqk,bkhd->bqhd', a.astype(v.dtype), v)

    out = lax.map(one_block, (qb, jnp.arange(nb)))
    out = jnp.moveaxis(out, 0, 1).reshape(B, S, H, v.shape[-1]).astype(jnp.float32)
    out = out * lax.rsqrt(jnp.mean(jnp.square(out), axis=-1, keepdims=True) + EPS)
    out = out * head_gain.astype(jnp.float32) * (1.0 - lam_init)
    return out.astype(v.dtype)


def _residue_view(x, dil):
    B, S = x.shape[:2]
    L = S // dil
    xr = jnp.moveaxis(x.reshape((B, L, dil) + x.shape[2:]), 2, 1).reshape((B * dil, L) + x.shape[2:])
    pad = (-L) % BLOCK
    return jnp.pad(xr, ((0, 0), (0, pad)) + ((0, 0),) * (x.ndim - 2))


def _residue_unview(y, B, dil, L):
    y = y[:, :L]
    y = jnp.moveaxis(y.reshape((B, dil) + y.shape[1:]), 1, 2)
    return y.reshape((B, dil * L) + y.shape[3:])


def dilated_attention(q, k, v, bias_table):
    B, S, H, D = q.shape
    scale = D ** -0.5
    qi = jnp.arange(BLOCK)
    kj = jnp.arange(2 * BLOCK)
    lag = BLOCK + qi[:, None] - kj[None, :]
    outs, maxes, sums = [], [], []
    for window, dil in DILATED_PATTERNS:
        L = S // dil
        qr, kr, vr = _residue_view(q, dil), _residue_view(k, dil), _residue_view(v, dil)
        N, Lp = qr.shape[:2]
        nb = Lp // BLOCK
        qb = qr.reshape(N, nb, BLOCK, H, D)
        kp = jnp.pad(kr, ((0, 0), (BLOCK, 0), (0, 0), (0, 0))).reshape(N, nb + 1, BLOCK, H, D)
        vp = jnp.pad(vr, ((0, 0), (BLOCK, 0), (0, 0), (0, 0))).reshape(N, nb + 1, BLOCK, H, D)
        kb = jnp.concatenate([kp[:, :-1], kp[:, 1:]], axis=2)
        vb = jnp.concatenate([vp[:, :-1], vp[:, 1:]], axis=2)
        key_idx = (jnp.arange(nb) * BLOCK - BLOCK)[:, None] + kj[None, :]
        valid = ((lag >= 0) & (lag <= window // dil))[None] & (key_idx >= 0)[:, None, :]
        bias = bias_table[t5_bucket(kj * dil)]
        bias_qk = bias[jnp.clip(lag, 0, 2 * BLOCK - 1)].astype(jnp.float32)
        s = jnp.einsum('nbqhd,nbkhd->nbhqk', qb, kb).astype(jnp.float32) * scale
        s = s + jnp.transpose(bias_qk, (2, 0, 1))[None, None]
        s = jnp.where(valid[None, :, None], s, -jnp.inf)
        m = jnp.max(s, axis=-1)
        p = jnp.exp(s - m[..., None])
        l = jnp.sum(p, axis=-1)
        o = jnp.einsum('nbhqk,nbkhd->nbqhd', p.astype(v.dtype), vb).astype(jnp.float32)
        l_t = jnp.swapaxes(l, 2, 3)
        o = o / l_t[..., None]
        outs.append(_residue_unview(o.reshape(N, Lp, H, D), B, dil, L))
        maxes.append(_residue_unview(jnp.swapaxes(m, 2, 3).reshape(N, Lp, H), B, dil, L))
        sums.append(_residue_unview(l_t.reshape(N, Lp, H), B, dil, L))
    m_all = jnp.stack(maxes)
    w = jnp.stack(sums) * jnp.exp(m_all - jnp.max(m_all, axis=0, keepdims=True))
    out = jnp.sum(w[..., None] * jnp.stack(outs), axis=0) / jnp.sum(w, axis=0)[..., None]
    return out.astype(q.dtype)


def conformer_conv(u, glu_gate, w_dw, b_dw, ln_g, ln_b, w_pw):
    h = u * jax.nn.sigmoid(glu_gate)
    h = lax.conv_general_dilated(h, w_dw[:, None, :], window_strides=(1,),
                                 padding=[(CONV_WIDTH - 1, 0)],
                                 dimension_numbers=('NWC', 'WIO', 'NWC'),
                                 feature_group_count=D_C) + b_dw
    h = jax.nn.silu(layer_norm(h, ln_g, ln_b))
    return h @ w_pw


def hybrid_layer(x, w_in, diff_lambda, diff_head_gain, conv_dw, conv_b, conv_ln_g, conv_ln_b,
                 conv_pw, w_out, ln_g, ln_b, rel_bias, lam_init):
    B, S, _ = x.shape
    proj = x @ w_in
    aq, ak, av, ag, bq, bk, bv, bg, cu, cglu, cg = jnp.split(proj, IN_OFFSETS, axis=-1)

    lam_v = diff_lambda.astype(jnp.float32)
    lam = (jnp.exp(jnp.sum(lam_v[0] * lam_v[1])) - jnp.exp(jnp.sum(lam_v[2] * lam_v[3]))
           + lam_init)
    bias_a = rel_bias[t5_bucket(jnp.arange(S))][:, :A_HEADS]
    ya = diff_attention(aq.reshape(B, S, A_HEADS, 2, A_QK_HALF),
                        ak.reshape(B, S, A_HEADS, 2, A_QK_HALF),
                        av.reshape(B, S, A_HEADS, A_HEAD_DIM),
                        bias_a, lam, lam_init, diff_head_gain).reshape(B, S, D_A)
    ya = ya * jax.nn.silu(ag)

    yb = dilated_attention(bq.reshape(B, S, B_HEADS, B_HEAD_DIM),
                           bk.reshape(B, S, B_HEADS, B_HEAD_DIM),
                           bv.reshape(B, S, B_HEADS, B_HEAD_DIM),
                           rel_bias[:, A_HEADS:]).reshape(B, S, D_B)
    yb = yb * jax.nn.silu(bg)

    yc = conformer_conv(cu, cglu, conv_dw, conv_b, conv_ln_g, conv_ln_b, conv_pw)
    yc = yc * jax.nn.silu(cg)

    y = jnp.concatenate([ya, yb, yc], axis=-1) @ w_out
    return layer_norm(ALPHA * x + y, ln_g, ln_b)


def setup_inputs(seed: int = 0) -> dict:
    key = jax.random.key(seed)
    ks = jax.random.split(key, 14)
    nrm = jax.random.normal
    return {
        "x": nrm(ks[0], (BATCH, SEQ, D_MODEL), jnp.float32),
        "w_in": nrm(ks[1], (DEPTH, D_MODEL, D_IN), jnp.float32) * D_MODEL ** -0.5,
        "diff_lambda": 0.1 * nrm(ks[2], (DEPTH, 4, A_QK_HALF), jnp.float32),
        "diff_head_gain": 1.0 + 0.02 * nrm(ks[3], (DEPTH, A_HEAD_DIM), jnp.float32),
        "conv_dw": nrm(ks[4], (DEPTH, CONV_WIDTH, D_C), jnp.float32) * CONV_WIDTH ** -0.5,
        "conv_b": 0.02 * nrm(ks[5], (DEPTH, D_C), jnp.float32),
        "conv_ln_g": 1.0 + 0.02 * nrm(ks[6], (DEPTH, D_C), jnp.float32),
        "conv_ln_b": 0.02 * nrm(ks[7], (DEPTH, D_C), jnp.float32),
        "conv_pw": nrm(ks[8], (DEPTH, D_C, D_C), jnp.float32) * D_C ** -0.5,
        "w_out": nrm(ks[9], (DEPTH, D_MIX, D_MODEL), jnp.float32) * (D_MIX ** -0.5 * BETA),
        "ln_g": 1.0 + 0.02 * nrm(ks[10], (DEPTH, D_MODEL), jnp.float32),
        "ln_b": 0.02 * nrm(ks[11], (DEPTH, D_MODEL), jnp.float32),
        "rel_bias": 0.5 * nrm(ks[12], (N_BUCKETS, N_ATTN_HEADS), jnp.float32),
    }


def reference(x, w_in, diff_lambda, diff_head_gain, conv_dw, conv_b, conv_ln_g, conv_ln_b,
              conv_pw, w_out, ln_g, ln_b, rel_bias):
    for layer in range(DEPTH):
        lam_init = 0.8 - 0.6 * math.exp(-0.3 * layer)
        x = hybrid_layer(x, w_in[layer], diff_lambda[layer], diff_head_gain[layer],
                         conv_dw[layer], conv_b[layer], conv_ln_g[layer], conv_ln_b[layer],
                         conv_pw[layer], w_out[layer], ln_g[layer], ln_b[layer], rel_bias,
                         lam_init)
    return x
```

```cpp
#include <hip/hip_runtime.h>
#include <hip/hip_cooperative_groups.h>
#include <cstdio>
#include <cstdint>
namespace pg8 {
#define PG8_LAS __attribute__((address_space(3)))
typedef unsigned short bf16_t;
typedef short bf16x8 __attribute__((ext_vector_type(8)));
typedef float f32x4 __attribute__((ext_vector_type(4)));
typedef unsigned u32x4 __attribute__((ext_vector_type(4)));
constexpr int BM = 256, BK = 64, HALF = 128, HTB = HALF * BK * 2  , STAGE_BYTES = 8 * HTB, NXCD = 8, WGM = 8;

__host__ __device__ __forceinline__ int lds_byte(int r, int c) { const int st = (r >> 4) * 2 + (c >> 5), rr = r & 15, cc = c & 31, ob = rr * 64 + cc * 2; return st * 1024 + (ob ^ (((ob >> 9) & 1) << 5)); }
__host__ __device__ __forceinline__ void stage_rc(int b, int& R, int& C) { const int st = b / 1024, sb = b % 1024, swz = sb ^ (((sb >> 9) & 1) << 5); R = (st >> 1) * 16 + swz / 64; C = (st & 1) * 32 + (swz % 64) / 2; }
__host__ __device__ __forceinline__ int perm32(int rho) { const int n = rho >> 4, i = rho & 15; return 8 * (i >> 2) + 4 * n + (i & 3); }

struct Unit { int pm, pn; };
struct Gemm { const bf16_t* A; const bf16_t* Bt; int M, N, K; };

struct StaticOrder {
    int nM, nN, nwg, G, c;
    __host__ __device__ void init(int M, int N, int G_, int c_) { nM = M / BM; nN = N / BM; nwg = nM * nN; G = G_; c = c_; }
    __host__ __device__ bool next(int i, Unit& u) const {
        const long L = (long)i * G + c; if (L >= nwg) return false;
        int wgid = (int)L; { const int q = nwg / NXCD, r = nwg % NXCD, xcd = wgid % NXCD, off = wgid / NXCD; wgid = (xcd < r ? xcd * (q + 1) : r * (q + 1) + (xcd - r) * q) + off; }
        const int nig = WGM * nN, gid = wgid / nig, fm = gid * WGM, gsz = (nM - fm) < WGM ? (nM - fm) : WGM;
        u.pm = fm + ((wgid % nig) % gsz); u.pn = (wgid % nig) / gsz; return true;
    }
    __device__ __forceinline__ void a_ready(const Unit&) const {}
    __device__ __forceinline__ void done(const Unit&) const {}
};

__device__ __forceinline__ unsigned cvt_pk_bf16(float lo, float hi) { unsigned r; asm volatile("v_cvt_pk_bf16_f32 %0, %1, %2" : "=v"(r) : "v"(lo), "v"(hi)); return r; }
typedef float f32x2 __attribute__((ext_vector_type(2)));
__device__ __forceinline__ f32x2 gelu_pk(f32x2 v) {
    const f32x2 av = __builtin_elementwise_abs(v), d = av * 0.2316418882f + 1.0f;
    f32x2 t; t.x = __builtin_amdgcn_rcpf(d.x); t.y = __builtin_amdgcn_rcpf(d.y);
    f32x2 q = t * 0.5307027145f + (-0.7265760135f); q = q * t + 0.7107068705f; q = q * t + (-0.142248368f); q = q * t + 0.127414796f; q = q * t;
    const f32x2 s = (v * v) * (-0.72134752044f);
    f32x2 e; e.x = __builtin_amdgcn_exp2f(s.x); e.y = __builtin_amdgcn_exp2f(s.y);
    const f32x2 m = v * (q * e), r = v - m;
    f32x2 o; o.x = v.x < 0.f ? m.x : r.x; o.y = v.y < 0.f ? m.y : r.y; return o;
}

template <int ACT  > struct EpiBf16 {
    static constexpr bool PERM = true, AFTER_DRAIN = false; static_assert(ACT == 0 || ACT == 1, "EpiBf16: ACT is 0 (none) or 1 (gelu_pk)");
    bf16_t* O; int ldc; const float* bias; int split_cols; size_t split_stride; float scale0;
    __device__ __forceinline__ void operator()(const f32x4 (&acc)[2][2][4][2], const Unit& u, int wr, int wc, int fr, int fq) const {
        const int row0 = u.pm * BM + wr * 64 + fr; int colt = u.pn * BM; bf16_t* base = O;
        float sc = 1.f; if (split_cols) { const int t = colt / split_cols; base += (size_t)t * split_stride; colt -= t * split_cols; if (t == 0) sc = scale0; }
        const int col0 = colt + wc * 32 + 8 * fq, bcol0 = u.pn * BM + wc * 32 + 8 * fq;
        f32x4 bv[2][2];
#pragma unroll
        for (int bj = 0; bj < 2; ++bj)
#pragma unroll
            for (int n = 0; n < 2; ++n) bv[bj][n] = bias ? *(const f32x4*)(bias + bcol0 + bj * HALF + 4 * n) : (f32x4){0.f, 0.f, 0.f, 0.f};
#pragma unroll
        for (int ai = 0; ai < 2; ++ai)
#pragma unroll
            for (int m = 0; m < 4; ++m) { bf16_t* rowp = base + (size_t)(row0 + ai * HALF + m * 16) * ldc + col0;
#pragma unroll
                for (int bj = 0; bj < 2; ++bj) { f32x4 v0 = acc[ai][bj][m][0] + bv[bj][0], v1 = acc[ai][bj][m][1] + bv[bj][1];
                    if (ACT == 1) { f32x2 a = gelu_pk((f32x2){v0[0], v0[1]}), b = gelu_pk((f32x2){v0[2], v0[3]}), c = gelu_pk((f32x2){v1[0], v1[1]}), d = gelu_pk((f32x2){v1[2], v1[3]});
                        v0 = (f32x4){a.x, a.y, b.x, b.y}; v1 = (f32x4){c.x, c.y, d.x, d.y}; }
                    v0 = v0 * sc; v1 = v1 * sc; u32x4 w; w.x = cvt_pk_bf16(v0[0], v0[1]); w.y = cvt_pk_bf16(v0[2], v0[3]); w.z = cvt_pk_bf16(v1[0], v1[1]); w.w = cvt_pk_bf16(v1[2], v1[3]);
                    *(u32x4*)(rowp + bj * HALF) = w; } }
    }
};

template <class Epi, class Sched, bool ALIGN_EPI = false, bool SP2 = false>
__device__ __forceinline__ void gemm_phase(PG8_LAS unsigned char* lds, const Gemm g, const Sched& S, const Epi& E) {
    int tid_ = threadIdx.x; asm volatile("" : "+v"(tid_));
    const int tid = tid_, wid = __builtin_amdgcn_readfirstlane(tid >> 6), lane = tid & 63, wr = wid >> 2, wc = wid & 3, fr = lane & 15, fq = lane >> 4;
    const int K = g.K, nt = K / BK;
    unsigned voffA[2], voffB[2];
#pragma unroll
    for (int i = 0; i < 2; ++i) { int R, C; stage_rc(tid * 16 + i * 8192, R, C); const int Rb = Epi::PERM ? ((R & ~31) + perm32(R & 31)) : R;
        voffA[i] = (unsigned)(R * K + C) * 2u; voffB[i] = (unsigned)(Rb * K + C) * 2u; }
    const size_t kstep = (size_t)(BK * 2);
    const size_t hstep = (size_t)HALF * K * 2;
    const size_t tstep = 2 * hstep;
    const unsigned ldsw = (unsigned)wid * 1024u;
    const int aoff = lds_byte(wr * 64 + fr, fq * 8), boff = lds_byte(wc * 32 + fr, fq * 8);
#define PG8_SA(b, h) (((b) * 2 + (h)) * HTB)
#define PG8_SB(b, h) ((4 + (b) * 2 + (h)) * HTB)
#define PG8_STAGE(bufoff, gbase, voff) do { _Pragma("unroll") for (int _i = 0; _i < 2; ++_i) \
        __builtin_amdgcn_global_load_lds((const unsigned*)((const char*)(gbase) + (voff)[_i]), (PG8_LAS unsigned*)(lds + (bufoff) + ldsw + _i * 8192), 16, 0, 0); } while (0)
#define PG8_LDA(dst, b, h) do { _Pragma("unroll") for (int m = 0; m < 4; ++m) _Pragma("unroll") for (int k = 0; k < 2; ++k) dst[m][k] = *(const PG8_LAS bf16x8*)(lds + PG8_SA(b, h) + aoff + m * 2048 + k * 1024); } while (0)
#define PG8_LDB(dst, b, h) do { _Pragma("unroll") for (int n = 0; n < 2; ++n) _Pragma("unroll") for (int k = 0; k < 2; ++k) dst[n][k] = *(const PG8_LAS bf16x8*)(lds + PG8_SB(b, h) + boff + n * 2048 + k * 1024); } while (0)
#define PG8_MMA(ai, bj, At, Bt) do { __builtin_amdgcn_s_setprio(1); _Pragma("unroll") for (int m = 0; m < 4; ++m) _Pragma("unroll") for (int n = 0; n < 2; ++n) _Pragma("unroll") for (int k = 0; k < 2; ++k) \
        acc[ai][bj][m][n] = __builtin_amdgcn_mfma_f32_16x16x32_bf16(Bt[n][k], At[m][k], acc[ai][bj][m][n], 0, 0, 0); __builtin_amdgcn_s_setprio(0); } while (0)
#define PG8_WAIT_V(n) asm volatile("s_waitcnt vmcnt(" #n ")" ::: "memory")
#define PG8_WAIT_L(n) asm volatile("s_waitcnt lgkmcnt(" #n ")" ::: "memory")
#define PG8_BAR __builtin_amdgcn_s_barrier()
#define PG8_SCHED __builtin_amdgcn_sched_barrier(0)
    Unit cur, nxt; int ui = 0;
    if (!S.next(0, cur)) return;
    f32x4 acc[2][2][4][2];
#pragma unroll
    for (int a = 0; a < 2; ++a)
#pragma unroll
        for (int b = 0; b < 2; ++b)
#pragma unroll
            for (int m = 0; m < 4; ++m)
#pragma unroll
                for (int n = 0; n < 2; ++n) acc[a][b][m][n] = (f32x4){0.f, 0.f, 0.f, 0.f};
    bf16x8 At[4][2], B0[2][2], B1[2][2];
    const char* cA = (const char*)g.A + (size_t)cur.pm * tstep; const char* cB = (const char*)g.Bt + (size_t)cur.pn * tstep;
    S.a_ready(cur);
    if constexpr (SP2) {
        PG8_STAGE(PG8_SB(0, 0), cB, voffB); PG8_STAGE(PG8_SB(0, 1), cB + hstep, voffB); PG8_STAGE(PG8_SA(0, 0), cA, voffA); PG8_STAGE(PG8_SA(0, 1), cA + hstep, voffA);
        if (wr == 1) PG8_BAR;
        PG8_WAIT_V(2); PG8_BAR;
        PG8_STAGE(PG8_SB(1, 0), cB + kstep, voffB); PG8_STAGE(PG8_SA(1, 0), cA + kstep, voffA); PG8_STAGE(PG8_SB(1, 1), cB + hstep + kstep, voffB);
        PG8_WAIT_V(6); PG8_BAR;
    } else {
        PG8_STAGE(PG8_SB(0, 0), cB, voffB); PG8_STAGE(PG8_SA(0, 0), cA, voffA); PG8_STAGE(PG8_SB(0, 1), cB + hstep, voffB); PG8_STAGE(PG8_SA(0, 1), cA + hstep, voffA);
        if (wr == 1) PG8_BAR;
        PG8_WAIT_V(4); PG8_BAR;
        PG8_STAGE(PG8_SB(1, 0), cB + kstep, voffB); PG8_STAGE(PG8_SA(1, 0), cA + kstep, voffA); PG8_STAGE(PG8_SB(1, 1), cB + hstep + kstep, voffB);
        PG8_WAIT_V(6); PG8_BAR;
    }
    for (;;) {
        const bool has_next = S.next(ui + 1, nxt);
        const char* nA = has_next ? (const char*)g.A + (size_t)nxt.pm * tstep : cA; const char* nB = has_next ? (const char*)g.Bt + (size_t)nxt.pn * tstep : cB;
        for (int t = 0; t < nt; t += 2) {
            const bool last = (t == nt - 2);
            const char* a1 = cA + (size_t)(t + 1) * kstep;
            const char* a2 = last ? nA : cA + (size_t)(t + 2) * kstep; const char* b2 = last ? nB : cB + (size_t)(t + 2) * kstep;
            const char* a3 = a2 + kstep; const char* b3 = b2 + kstep;
            if (last && has_next) S.a_ready(nxt);
            if constexpr (SP2) {
            PG8_LDB(B0, 0, 0); PG8_LDB(B1, 0, 1); PG8_SCHED; PG8_LDA(At, 0, 0); PG8_STAGE(PG8_SA(1, 1), a1 + hstep, voffA);
            PG8_WAIT_V(8); PG8_WAIT_L(0); PG8_BAR; PG8_MMA(0, 0, At, B0); PG8_MMA(0, 1, At, B1); PG8_BAR; PG8_SCHED;
            PG8_LDA(At, 0, 1); PG8_STAGE(PG8_SB(0, 0), b2, voffB); PG8_STAGE(PG8_SB(0, 1), b2 + hstep, voffB); PG8_STAGE(PG8_SA(0, 0), a2, voffA);
            PG8_WAIT_V(8); PG8_WAIT_L(0); PG8_BAR; PG8_MMA(1, 0, At, B0); PG8_MMA(1, 1, At, B1); PG8_BAR; PG8_SCHED;
            PG8_LDB(B0, 1, 0); PG8_LDB(B1, 1, 1); PG8_SCHED; PG8_LDA(At, 1, 0); PG8_STAGE(PG8_SA(0, 1), a2 + hstep, voffA);
            PG8_WAIT_V(8); PG8_WAIT_L(0); PG8_BAR; PG8_MMA(0, 0, At, B0); PG8_MMA(0, 1, At, B1); PG8_BAR; PG8_SCHED;
            PG8_LDA(At, 1, 1); PG8_STAGE(PG8_SB(1, 0), b3, voffB); PG8_STAGE(PG8_SB(1, 1), b3 + hstep, voffB); PG8_STAGE(PG8_SA(1, 0), a3, voffA);
            PG8_WAIT_V(8); PG8_WAIT_L(0); PG8_BAR; PG8_MMA(1, 0, At, B0); PG8_MMA(1, 1, At, B1); PG8_BAR; PG8_SCHED;
            } else {
            PG8_LDB(B0, 0, 0); PG8_SCHED; PG8_LDA(At, 0, 0); PG8_STAGE(PG8_SA(1, 1), a1 + hstep, voffA);
            PG8_WAIT_L(8); PG8_BAR; PG8_WAIT_L(0); PG8_MMA(0, 0, At, B0); PG8_BAR; PG8_SCHED;
            PG8_LDB(B1, 0, 1); PG8_STAGE(PG8_SB(0, 0), b2, voffB);
            PG8_BAR; PG8_WAIT_L(0); PG8_MMA(0, 1, At, B1); PG8_BAR;
            PG8_LDA(At, 0, 1); PG8_STAGE(PG8_SA(0, 0), a2, voffA);
            PG8_BAR; PG8_WAIT_L(0); PG8_MMA(1, 0, At, B0); PG8_BAR; PG8_SCHED;
            PG8_STAGE(PG8_SB(0, 1), b2 + hstep, voffB);
            PG8_WAIT_V(6); PG8_BAR; PG8_MMA(1, 1, At, B1); PG8_BAR;
            PG8_LDB(B0, 1, 0); PG8_SCHED; PG8_LDA(At, 1, 0); PG8_STAGE(PG8_SA(0, 1), a2 + hstep, voffA);
            PG8_WAIT_L(8); PG8_BAR; PG8_WAIT_L(0); PG8_MMA(0, 0, At, B0); PG8_BAR; PG8_SCHED;
            PG8_LDB(B1, 1, 1); PG8_STAGE(PG8_SB(1, 0), b3, voffB);
            PG8_BAR; PG8_WAIT_L(0); PG8_MMA(0, 1, At, B1); PG8_BAR;
            PG8_LDA(At, 1, 1); PG8_STAGE(PG8_SA(1, 0), a3, voffA);
            PG8_BAR; PG8_WAIT_L(0); PG8_MMA(1, 0, At, B0); PG8_BAR; PG8_SCHED;
            PG8_STAGE(PG8_SB(1, 1), b3 + hstep, voffB);
            PG8_WAIT_V(6); PG8_BAR; PG8_MMA(1, 1, At, B1); PG8_BAR;
            }
        }
        if constexpr (ALIGN_EPI) { if (wr == 0) PG8_BAR; }
        if constexpr (!Epi::AFTER_DRAIN) { E(acc, cur, wr, wc, fr, fq); S.done(cur); }
        if (!has_next) break;
#pragma unroll
        for (int a = 0; a < 2; ++a)
#pragma unroll
            for (int b = 0; b < 2; ++b)
#pragma unroll
                for (int m = 0; m < 4; ++m)
#pragma unroll
                    for (int n = 0; n < 2; ++n) acc[a][b][m][n] = (f32x4){0.f, 0.f, 0.f, 0.f};
        cur = nxt; cA = nA; cB = nB; ++ui;
        if constexpr (ALIGN_EPI) { if (wr == 1) PG8_BAR; }
    }
    PG8_WAIT_V(0);
    if constexpr (!ALIGN_EPI) { if (wr == 0) PG8_BAR; }
    PG8_BAR;
    if constexpr (Epi::AFTER_DRAIN) { E.fused(acc, cur, wr, wc, fr, fq, lds, wid, lane); S.done(cur); }
#undef PG8_SA
#undef PG8_SB
#undef PG8_STAGE
#undef PG8_LDA
#undef PG8_LDB
#undef PG8_MMA
#undef PG8_WAIT_V
#undef PG8_WAIT_L
#undef PG8_BAR
#undef PG8_SCHED
}
}

constexpr int BATCH = 8, SEQ = 2048, DM = 2048, MROWS = BATCH * SEQ, DIN = 7680, DEPTH = 2;
constexpr int C_AQ = 0, C_AK = 512, C_AV = 1024, C_AG = 1536, C_BQ = 2048, C_BK = 3072, C_BV = 4096, C_BG = 5120, C_CU = 6144, C_CGLU = 6656, C_CG = 7168;
constexpr int Y_A = 0, Y_B = 512, Y_C = 1536;
constexpr int DC = 512, CONVW = 31;
constexpr float LN_EPS = 1e-5f;
constexpr float ALPHA = 1.41421356237309515f;
constexpr int NWAVES = 8;
constexpr int LDS_BYTES = 147456;

constexpr size_t MiB = 1u << 20;
constexpr size_t WS_CTL = 0, CTL_ZERO_BYTES = 64 * 1024;
constexpr size_t WS_TAB = 1 * MiB;
constexpr size_t TAB_BIASA = 0, TAB_BIASB = 32 * 1024, TAB_LAM = 64 * 1024;
constexpr size_t WS_WIN = 2 * MiB;
constexpr size_t WS_WOUT = 62 * MiB;
constexpr size_t WS_WPW = 78 * MiB;
constexpr size_t WS_XB = 80 * MiB;
constexpr size_t WS_Y = 144 * MiB;
constexpr size_t WS_PROJ = 208 * MiB;
constexpr size_t WS_END = 448 * MiB;

#define GAS __attribute__((address_space(1)))
#define LAS __attribute__((address_space(3)))
typedef unsigned short bf16;
typedef unsigned v4u __attribute__((ext_vector_type(4)));
typedef unsigned v2u __attribute__((ext_vector_type(2)));
typedef float f32x4 __attribute__((ext_vector_type(4)));
#define LDS_WAIT() asm volatile("s_waitcnt lgkmcnt(0)" ::: "memory")
#define VM_WAIT() asm volatile("s_waitcnt vmcnt(0)" ::: "memory")

__device__ __forceinline__ unsigned f2bf(float f) { unsigned u = __builtin_bit_cast(unsigned, f); return (u + 0x7fffu + ((u >> 16) & 1u)) >> 16; }
__device__ __forceinline__ unsigned pk2(float lo, float hi) { return f2bf(lo) | (f2bf(hi) << 16); }
__device__ __forceinline__ float bflo(unsigned u) { return __uint_as_float(u << 16); }
__device__ __forceinline__ float bfhi(unsigned u) { return __uint_as_float(u & 0xffff0000u); }
__device__ __forceinline__ float wave_sum(float v) {
#pragma unroll
    for (int o = 1; o < 64; o <<= 1) v += __shfl_xor(v, o);
    return v;
}
__device__ __forceinline__ float wave_max(float v) {
#pragma unroll
    for (int o = 1; o < 64; o <<= 1) v = fmaxf(v, __shfl_xor(v, o));
    return v;
}
__device__ __forceinline__ float dot8(v4u a, v4u b, float s) {
    s += bflo(a.x) * bflo(b.x); s += bfhi(a.x) * bfhi(b.x); s += bflo(a.y) * bflo(b.y); s += bfhi(a.y) * bfhi(b.y);
    s += bflo(a.z) * bflo(b.z); s += bfhi(a.z) * bfhi(b.z); s += bflo(a.w) * bflo(b.w); s += bfhi(a.w) * bfhi(b.w);
    return s;
}
__device__ __forceinline__ float silu_f(float x) { return x / (1.f + __expf(-x)); }
__device__ __forceinline__ float sigmoid_f(float x) { return 1.f / (1.f + __expf(-x)); }
__device__ __forceinline__ int t5_bucket(int d) {
    if (d < 16) return d;
    int v = 16 + (int)(logf((float)d * (1.f / 16.f)) / 4.852030263919617f * 16.f);
    return v < 31 ? v : 31;
}
__host__ __device__ __forceinline__ float lam_init_of(int layer) { return layer == 0 ? 0.2f : 0.35550906759f; }

struct EpiResid {
    static constexpr bool PERM = false, AFTER_DRAIN = false;
    const float* res; float* out; int ldc; float alpha;
    __device__ __forceinline__ void operator()(const pg8::f32x4 (&acc)[2][2][4][2], const pg8::Unit& u, int wr, int wc, int fr, int fq) const {
        const int row0 = u.pm * pg8::BM + wr * 64 + fr, col0 = u.pn * pg8::BM + wc * 32 + 4 * fq;
#pragma unroll
        for (int ai = 0; ai < 2; ++ai)
#pragma unroll
            for (int m = 0; m < 4; ++m) { const size_t off = (size_t)(row0 + ai * pg8::HALF + m * 16) * ldc + col0;
                pg8::f32x4 r[2][2];
#pragma unroll
                for (int bj = 0; bj < 2; ++bj)
#pragma unroll
                    for (int n = 0; n < 2; ++n) r[bj][n] = *(const pg8::f32x4*)(res + off + bj * pg8::HALF + n * 16);
#pragma unroll
                for (int bj = 0; bj < 2; ++bj)
#pragma unroll
                    for (int n = 0; n < 2; ++n) *(pg8::f32x4*)(out + off + bj * pg8::HALF + n * 16) = r[bj][n] * alpha + acc[ai][bj][m][n];
                asm volatile("" ::: "memory"); }
    }
};

struct Frame {
    LAS unsigned char* lds;
    int G;
    const float *x, *w_in, *diff_lambda, *head_gain, *conv_dw, *conv_b, *conv_ln_g, *conv_ln_b, *conv_pw, *w_out, *ln_g, *ln_b, *rel_bias;
    float* out;
    bf16 *win_t, *wout_t, *wpw_t, *xb, *ymix, *proj;
    float *biasA, *biasB, *lamv;
};

#define PHASE_IDS() int tid_ = threadIdx.x; asm volatile("" : "+v"(tid_)); const int tid = tid_, lane = tid & 63, wave = __builtin_amdgcn_readfirstlane(tid >> 6); (void)tid; (void)lane; (void)wave
__device__ __forceinline__ void p0_transpose_item(const float* W, int K, int N, bf16* WT, LAS float* scr, int item, int lane) {
    const int nblk = N / 32, kb = item / nblk, nb = item % nblk, k0 = 64 * kb, n0 = 32 * nb;
#pragma unroll 8
    for (int i = 0; i < 32; ++i) { const int kk = 2 * i + (lane >> 5); scr[kk * 33 + (lane & 31)] = W[(size_t)(k0 + kk) * N + n0 + (lane & 31)]; }
    LDS_WAIT(); asm volatile("" ::: "memory");
    const int c = lane & 7;
#pragma unroll
    for (int j = 0; j < 4; ++j) { const int n = (lane >> 3) + 8 * j; const LAS float* s = scr + (8 * c) * 33 + n;
        v4u o; o.x = pk2(s[0 * 33], s[1 * 33]); o.y = pk2(s[2 * 33], s[3 * 33]); o.z = pk2(s[4 * 33], s[5 * 33]); o.w = pk2(s[6 * 33], s[7 * 33]);
        *(GAS v4u*)(WT + (size_t)(n0 + n) * K + k0 + 8 * c) = o; }
    LDS_WAIT(); asm volatile("" ::: "memory");
}

__device__ __forceinline__ void p0_prologue(Frame& F) {
    PHASE_IDS();
    LAS float* scr = (LAS float*)(F.lds + wave * 16384);
    const int gw = blockIdx.x * NWAVES + wave, NGW = F.G * NWAVES;
    constexpr int I_IN = (DM / 64) * (DIN / 32), I_OUT = (DM / 64) * (DM / 32), I_PW = (DC / 64) * (DC / 32);
    constexpr int NITEMS = DEPTH * (I_IN + I_OUT + I_PW);
    for (int it = gw; it < NITEMS; it += NGW) {
        int r = it;
        if (r < DEPTH * I_IN) { const int l = r / I_IN; r -= l * I_IN; p0_transpose_item(F.w_in + (size_t)l * DM * DIN, DM, DIN, F.win_t + (size_t)l * DIN * DM, scr, r, lane); continue; }
        r -= DEPTH * I_IN;
        if (r < DEPTH * I_OUT) { const int l = r / I_OUT; r -= l * I_OUT; p0_transpose_item(F.w_out + (size_t)l * DM * DM, DM, DM, F.wout_t + (size_t)l * DM * DM, scr, r, lane); continue; }
        r -= DEPTH * I_OUT;
        { const int l = r / I_PW; r -= l * I_PW; p0_transpose_item(F.conv_pw + (size_t)l * DC * DC, DC, DC, F.wpw_t + (size_t)l * DC * DC, scr, r, lane); }
    }
    { const size_t n8 = (size_t)MROWS * DM / 8;
      for (size_t i = (size_t)gw * 64 + lane; i < n8; i += (size_t)NGW * 64) {
          const f32x4 a = *(const GAS f32x4*)(F.x + i * 8), b = *(const GAS f32x4*)(F.x + i * 8 + 4);
          v4u o; o.x = pk2(a.x, a.y); o.y = pk2(a.z, a.w); o.z = pk2(b.x, b.y); o.w = pk2(b.z, b.w);
          *(GAS v4u*)(F.xb + i * 8) = o; } }
    { const int gt = blockIdx.x * (NWAVES * 64) + tid, NT = F.G * NWAVES * 64;
      for (int i = gt; i < 4 * 2048; i += NT) { const int h = i >> 11, d = i & 2047; F.biasA[i] = F.rel_bias[t5_bucket(d) * 12 + h]; }
      for (int i = gt; i < 3 * 8 * 132; i += NT) { const int p = i / (8 * 132), h = (i / 132) % 8, j = i % 132; const int dil = p == 0 ? 1 : (p == 1 ? 4 : 16);
          F.biasB[i] = (j <= 128) ? F.rel_bias[t5_bucket(j * dil) * 12 + 4 + h] : 0.f; }
      if (gt < DEPTH) { const float* lv = F.diff_lambda + gt * 4 * 64; float s0 = 0.f, s1 = 0.f;
          for (int i = 0; i < 64; ++i) { s0 += lv[i] * lv[64 + i]; s1 += lv[128 + i] * lv[192 + i]; }
          F.lamv[gt] = expf(s0) - expf(s1) + lam_init_of(gt); } }
}

__device__ __forceinline__ void naive_mixer_a(Frame& F, int layer) {
    PHASE_IDS();
    LAS float* sc = (LAS float*)(F.lds) + wave * 4096;
    const float lam = F.lamv[layer], li = lam_init_of(layer);
    const int gw = blockIdx.x * NWAVES + wave, NGW = F.G * NWAVES;
    for (int item = gw; item < MROWS * 4; item += NGW) {
        const int h = item & 3, bt = item >> 2, t = bt & (SEQ - 1), b = bt >> 11;
        const bf16* base = F.proj + (size_t)(b * SEQ) * DIN;
        const bf16* qp = base + (size_t)t * DIN + C_AQ + h * 128;
        v4u q[16];
#pragma unroll
        for (int i = 0; i < 16; ++i) q[i] = *(const GAS v4u*)(qp + i * 8);
        float m0 = -INFINITY, m1 = -INFINITY;
        for (int k = lane; k <= t; k += 64) {
            const bf16* kp = base + (size_t)k * DIN + C_AK + h * 128;
            float s0 = 0.f, s1 = 0.f;
#pragma unroll
            for (int i = 0; i < 8; ++i) s0 = dot8(q[i], *(const GAS v4u*)(kp + i * 8), s0);
#pragma unroll
            for (int i = 8; i < 16; ++i) s1 = dot8(q[i], *(const GAS v4u*)(kp + i * 8), s1);
            const float bias = F.biasA[h * 2048 + (t - k)];
            s0 = s0 * 0.125f + bias; s1 = s1 * 0.125f + bias;
            sc[k] = s0; sc[2048 + k] = s1; m0 = fmaxf(m0, s0); m1 = fmaxf(m1, s1);
        }
        m0 = wave_max(m0); m1 = wave_max(m1);
        float l0 = 0.f, l1 = 0.f;
        for (int k = lane; k <= t; k += 64) { const float p0 = __expf(sc[k] - m0), p1 = __expf(sc[2048 + k] - m1); sc[k] = p0; sc[2048 + k] = p1; l0 += p0; l1 += p1; }
        l0 = wave_sum(l0); l1 = wave_sum(l1);
        const float i0 = 1.f / l0, i1 = lam / l1;
        for (int k = lane; k <= t; k += 64) sc[k] = sc[k] * i0 - sc[2048 + k] * i1;
        LDS_WAIT(); asm volatile("" ::: "memory");
        float a0 = 0.f, a1 = 0.f;
        const bf16* vp = base + C_AV + h * 128 + 2 * lane;
        for (int k = 0; k <= t; ++k) { const float a = sc[k]; const unsigned v = *(const GAS unsigned*)(vp + (size_t)k * DIN); a0 += a * bflo(v); a1 += a * bfhi(v); }
        const float ss = wave_sum(a0 * a0 + a1 * a1);
        const float r = rsqrtf(ss * (1.f / 128.f) + LN_EPS) * (1.f - li);
        const float g0 = F.head_gain[layer * 128 + 2 * lane], g1 = F.head_gain[layer * 128 + 2 * lane + 1];
        const unsigned ag = *(const GAS unsigned*)(base + (size_t)t * DIN + C_AG + h * 128 + 2 * lane);
        const float o0 = a0 * r * g0 * silu_f(bflo(ag)), o1 = a1 * r * g1 * silu_f(bfhi(ag));
        *(GAS unsigned*)(F.ymix + (size_t)(b * SEQ + t) * DM + Y_A + h * 128 + 2 * lane) = pk2(o0, o1);
        LDS_WAIT(); asm volatile("" ::: "memory");
    }
}

__device__ __forceinline__ void naive_mixer_b(Frame& F, int layer) {
    PHASE_IDS();
    LAS float* sc = (LAS float*)(F.lds) + wave * 512;
    const int gw = blockIdx.x * NWAVES + wave, NGW = F.G * NWAVES;
    const float scale = 0.08838834764831845f;
    for (int item = gw; item < MROWS * 8; item += NGW) {
        const int h = item & 7, bt = item >> 3, t = bt & (SEQ - 1), b = bt >> 11;
        const bf16* base = F.proj + (size_t)(b * SEQ) * DIN;
        const bf16* qp = base + (size_t)t * DIN + C_BQ + h * 128;
        v4u q[16];
#pragma unroll
        for (int i = 0; i < 16; ++i) q[i] = *(const GAS v4u*)(qp + i * 8);
        float m = -INFINITY;
#pragma unroll
        for (int p = 0; p < 3; ++p) { const int dil = p == 0 ? 1 : (p == 1 ? 4 : 16);
            for (int j = lane; j <= 128; j += 64) { const int tk = t - j * dil; float s = -INFINITY;
                if (tk >= 0) { const bf16* kp = base + (size_t)tk * DIN + C_BK + h * 128; s = 0.f;
#pragma unroll
                    for (int i = 0; i < 16; ++i) s = dot8(q[i], *(const GAS v4u*)(kp + i * 8), s);
                    s = s * scale + F.biasB[(p * 8 + h) * 132 + j]; }
                sc[p * 132 + j] = s; m = fmaxf(m, s); } }
        m = wave_max(m);
        float l = 0.f;
#pragma unroll
        for (int p = 0; p < 3; ++p) for (int j = lane; j <= 128; j += 64) { const float e = __expf(sc[p * 132 + j] - m); sc[p * 132 + j] = e; l += e; }
        l = wave_sum(l);
        LDS_WAIT(); asm volatile("" ::: "memory");
        float a0 = 0.f, a1 = 0.f;
        const bf16* vp = base + C_BV + h * 128 + 2 * lane;
#pragma unroll
        for (int p = 0; p < 3; ++p) { const int dil = p == 0 ? 1 : (p == 1 ? 4 : 16); int jmax = t / dil; jmax = jmax < 128 ? jmax : 128;
            for (int j = 0; j <= jmax; ++j) { const float a = sc[p * 132 + j]; const unsigned v = *(const GAS unsigned*)(vp + (size_t)(t - j * dil) * DIN); a0 += a * bflo(v); a1 += a * bfhi(v); } }
        const float il = 1.f / l;
        const unsigned bg = *(const GAS unsigned*)(base + (size_t)t * DIN + C_BG + h * 128 + 2 * lane);
        *(GAS unsigned*)(F.ymix + (size_t)(b * SEQ + t) * DM + Y_B + h * 128 + 2 * lane) = pk2(a0 * il * silu_f(bflo(bg)), a1 * il * silu_f(bfhi(bg)));
        LDS_WAIT(); asm volatile("" ::: "memory");
    }
}

__device__ __forceinline__ void naive_mixer_c(Frame& F, int layer) {
    PHASE_IDS();
    LAS float* hb = (LAS float*)(F.lds) + wave * 512;
    const int gw = blockIdx.x * NWAVES + wave, NGW = F.G * NWAVES, c0 = lane * 8;
    const float* dw = F.conv_dw + (size_t)layer * CONVW * DC; const float* pw = F.conv_pw + (size_t)layer * DC * DC;
    for (int item = gw; item < MROWS; item += NGW) {
        const int t = item & (SEQ - 1), b = item >> 11;
        const bf16* base = F.proj + (size_t)(b * SEQ) * DIN;
        float acc[8];
#pragma unroll
        for (int i = 0; i < 8; ++i) acc[i] = F.conv_b[layer * DC + c0 + i];
        for (int j = 0; j < CONVW; ++j) { const int tk = t - (CONVW - 1) + j; if (tk < 0) continue;
            const v4u u = *(const GAS v4u*)(base + (size_t)tk * DIN + C_CU + c0), g = *(const GAS v4u*)(base + (size_t)tk * DIN + C_CGLU + c0);
            const f32x4 w0 = *(const GAS f32x4*)(dw + j * DC + c0), w1 = *(const GAS f32x4*)(dw + j * DC + c0 + 4);
            acc[0] += w0.x * (bflo(u.x) * sigmoid_f(bflo(g.x))); acc[1] += w0.y * (bfhi(u.x) * sigmoid_f(bfhi(g.x)));
            acc[2] += w0.z * (bflo(u.y) * sigmoid_f(bflo(g.y))); acc[3] += w0.w * (bfhi(u.y) * sigmoid_f(bfhi(g.y)));
            acc[4] += w1.x * (bflo(u.z) * sigmoid_f(bflo(g.z))); acc[5] += w1.y * (bfhi(u.z) * sigmoid_f(bfhi(g.z)));
            acc[6] += w1.z * (bflo(u.w) * sigmoid_f(bflo(g.w))); acc[7] += w1.w * (bfhi(u.w) * sigmoid_f(bfhi(g.w))); }
        float s = 0.f;
#pragma unroll
        for (int i = 0; i < 8; ++i) s += acc[i];
        const float mean = wave_sum(s) * (1.f / DC); float s2 = 0.f;
#pragma unroll
        for (int i = 0; i < 8; ++i) { acc[i] -= mean; s2 += acc[i] * acc[i]; }
        const float rstd = rsqrtf(wave_sum(s2) * (1.f / DC) + LN_EPS);
#pragma unroll
        for (int i = 0; i < 8; ++i) { const float hn = acc[i] * rstd * F.conv_ln_g[layer * DC + c0 + i] + F.conv_ln_b[layer * DC + c0 + i]; hb[c0 + i] = silu_f(hn); }
        LDS_WAIT(); asm volatile("" ::: "memory");
        float o[8];
#pragma unroll
        for (int i = 0; i < 8; ++i) o[i] = 0.f;
        for (int c = 0; c < DC; ++c) { const float hv = hb[c]; const f32x4 w0 = *(const GAS f32x4*)(pw + (size_t)c * DC + c0), w1 = *(const GAS f32x4*)(pw + (size_t)c * DC + c0 + 4);
            o[0] += hv * w0.x; o[1] += hv * w0.y; o[2] += hv * w0.z; o[3] += hv * w0.w; o[4] += hv * w1.x; o[5] += hv * w1.y; o[6] += hv * w1.z; o[7] += hv * w1.w; }
        const v4u cg = *(const GAS v4u*)(base + (size_t)t * DIN + C_CG + c0);
        v4u ov; ov.x = pk2(o[0] * silu_f(bflo(cg.x)), o[1] * silu_f(bfhi(cg.x))); ov.y = pk2(o[2] * silu_f(bflo(cg.y)), o[3] * silu_f(bfhi(cg.y)));
        ov.z = pk2(o[4] * silu_f(bflo(cg.z)), o[5] * silu_f(bfhi(cg.z))); ov.w = pk2(o[6] * silu_f(bflo(cg.w)), o[7] * silu_f(bfhi(cg.w)));
        *(GAS v4u*)(F.ymix + (size_t)(b * SEQ + t) * DM + Y_C + c0) = ov;
        LDS_WAIT(); asm volatile("" ::: "memory");
    }
}

__device__ __forceinline__ void ln_phase(Frame& F, int layer, bool write_xb) {
    PHASE_IDS();
    const int gw = blockIdx.x * NWAVES + wave, NGW = F.G * NWAVES;
    const float* g = F.ln_g + layer * DM; const float* bb = F.ln_b + layer * DM;
    for (int row = gw; row < MROWS; row += NGW) {
        GAS f32x4* xr = (GAS f32x4*)(F.out + (size_t)row * DM) + lane;
        f32x4 v[8]; float s = 0.f;
#pragma unroll
        for (int j = 0; j < 8; ++j) { v[j] = xr[64 * j]; s += (v[j].x + v[j].y) + (v[j].z + v[j].w); }
        const float mean = wave_sum(s) * (1.f / DM); float s2 = 0.f;
#pragma unroll
        for (int j = 0; j < 8; ++j) { v[j] = v[j] - mean; s2 += (v[j].x * v[j].x + v[j].y * v[j].y) + (v[j].z * v[j].z + v[j].w * v[j].w); }
        const float rstd = rsqrtf(wave_sum(s2) * (1.f / DM) + LN_EPS);
#pragma unroll
        for (int j = 0; j < 8; ++j) { const int c = 4 * lane + 256 * j; const f32x4 gv = *(const GAS f32x4*)(g + c), bv = *(const GAS f32x4*)(bb + c);
            const f32x4 o = v[j] * rstd * gv + bv; xr[64 * j] = o;
            if (write_xb) { v2u w; w.x = pk2(o.x, o.y); w.y = pk2(o.z, o.w); *(GAS v2u*)(F.xb + (size_t)row * DM + c) = w; } }
    }
}

struct Args { const float* in[13]; float* out; unsigned char* ws; int ph_lo, ph_hi; };
constexpr int N_PHASES = 1 + 4 * DEPTH;
#ifndef MK_ONE_LAUNCH
#define MK_ONE_LAUNCH 0
#endif

__global__ void __launch_bounds__(NWAVES * 64, 2) hymba_fwd(Args args) {
    extern __shared__ __attribute__((aligned(16))) unsigned char lds[];
    Frame F;
    F.lds = (LAS unsigned char*)lds;
    F.G = gridDim.x;
    unsigned char* ws = args.ws;
    F.x = args.in[0]; F.w_in = args.in[1]; F.diff_lambda = args.in[2]; F.head_gain = args.in[3]; F.conv_dw = args.in[4]; F.conv_b = args.in[5];
    F.conv_ln_g = args.in[6]; F.conv_ln_b = args.in[7]; F.conv_pw = args.in[8]; F.w_out = args.in[9]; F.ln_g = args.in[10]; F.ln_b = args.in[11]; F.rel_bias = args.in[12];
    F.out = args.out;
    F.win_t = (bf16*)(ws + WS_WIN); F.wout_t = (bf16*)(ws + WS_WOUT); F.wpw_t = (bf16*)(ws + WS_WPW); F.xb = (bf16*)(ws + WS_XB); F.ymix = (bf16*)(ws + WS_Y); F.proj = (bf16*)(ws + WS_PROJ);
    F.biasA = (float*)(ws + WS_TAB + TAB_BIASA); F.biasB = (float*)(ws + WS_TAB + TAB_BIASB); F.lamv = (float*)(ws + WS_TAB + TAB_LAM);
    const int lo = args.ph_lo, hi = args.ph_hi;
#define IN(k) (lo <= (k) && (k) < hi)
#if MK_ONE_LAUNCH
    cooperative_groups::grid_group grid = cooperative_groups::this_grid();
#define GRID_BAR() grid.sync()
#else
#define GRID_BAR() do {} while (0)
#endif
    if (IN(0)) { p0_prologue(F); if (IN(1)) GRID_BAR(); }
#pragma unroll
    for (int layer = 0; layer < DEPTH; ++layer) {
        const int p = 1 + 4 * layer;
        if (IN(p)) {
            pg8::Gemm g{F.xb, F.win_t + (size_t)layer * DIN * DM, MROWS, DIN, DM}; pg8::StaticOrder S; S.init(MROWS, DIN, F.G, (int)blockIdx.x);
            pg8::EpiBf16<0> E{F.proj, DIN, nullptr, 0, 0, 1.f};
            pg8::gemm_phase<pg8::EpiBf16<0>, pg8::StaticOrder, true, true>(F.lds, g, S, E);
            if (IN(p + 1)) GRID_BAR();
        }
        if (IN(p + 1)) {
            naive_mixer_a(F, layer); __syncthreads(); naive_mixer_b(F, layer); __syncthreads(); naive_mixer_c(F, layer); __syncthreads();
            if (IN(p + 2)) GRID_BAR();
        }
        if (IN(p + 2)) {
            pg8::Gemm g{F.ymix, F.wout_t + (size_t)layer * DM * DM, MROWS, DM, DM}; pg8::StaticOrder S; S.init(MROWS, DM, F.G, (int)blockIdx.x);
            EpiResid E{layer == 0 ? F.x : F.out, F.out, DM, ALPHA};
            pg8::gemm_phase<EpiResid, pg8::StaticOrder, true, true>(F.lds, g, S, E);
            if (IN(p + 3)) GRID_BAR();
        }
        if (IN(p + 3)) {
            ln_phase(F, layer, layer + 1 < DEPTH);
            if (IN(p + 4)) GRID_BAR();
        }
    }
#undef IN
}

extern "C" void kernel_launch(void* const* d_in, const int* in_sizes, int n_in, void* d_out, int out_size, void* d_ws, size_t ws_size, hipStream_t stream) {
    static int grid = 0;
    if (grid == 0) {
        if (n_in != 13 || in_sizes[0] != MROWS * DM || out_size != MROWS * DM || ws_size < WS_END) { fprintf(stderr, "kernel_launch: unexpected shapes (n_in %d, in0 %d, out %d, ws %zu)\n", n_in, n_in > 0 ? in_sizes[0] : -1, out_size, ws_size); grid = -1; return; }
        int dev = 0, cus = 0, per_cu = 0;
        if (hipGetDevice(&dev) != hipSuccess || hipDeviceGetAttribute(&cus, hipDeviceAttributeMultiprocessorCount, dev) != hipSuccess) { grid = -1; return; }
        if (hipFuncSetAttribute((const void*)hymba_fwd, hipFuncAttributeMaxDynamicSharedMemorySize, LDS_BYTES) != hipSuccess) { fprintf(stderr, "kernel_launch: hipFuncSetAttribute failed\n"); grid = -1; return; }
        if (hipOccupancyMaxActiveBlocksPerMultiprocessor(&per_cu, (const void*)hymba_fwd, NWAVES * 64, LDS_BYTES) != hipSuccess || per_cu < 1) { fprintf(stderr, "kernel_launch: occupancy query says %d\n", per_cu); per_cu = 1; }
        (void)hipGetLastError();
        grid = cus;
    }
    if (grid < 0) return;
    Args a{};
    for (int i = 0; i < 13; ++i) a.in[i] = (const float*)d_in[i];
    a.out = (float*)d_out; a.ws = (unsigned char*)d_ws;
#if MK_ONE_LAUNCH
    a.ph_lo = 0; a.ph_hi = N_PHASES;
    void* kargs[] = {&a};
    hipError_t e = hipLaunchCooperativeKernel((const void*)hymba_fwd, dim3(grid), dim3(NWAVES * 64), kargs, LDS_BYTES, stream);
    if (e != hipSuccess) fprintf(stderr, "kernel_launch: cooperative launch failed: %s (grid %d)\n", hipGetErrorString(e), grid);
#else
    for (int ph = 0; ph < N_PHASES; ++ph) {
        a.ph_lo = ph; a.ph_hi = ph + 1;
        hipLaunchKernelGGL(hymba_fwd, dim3(grid), dim3(NWAVES * 64), LDS_BYTES, stream, a);
        const hipError_t le = hipPeekAtLastError();
        if (le != hipSuccess) { fprintf(stderr, "kernel_launch: launch %d failed: %s\n", ph, hipGetErrorName(le)); break; }
    }
#endif
}
```

```cpp
#include <hip/hip_runtime.h>
#include <hip/hip_cooperative_groups.h>
#include <cstdio>
#include <cstdint>
namespace pg8 {
#define PG8_LAS __attribute__((address_space(3)))
typedef unsigned short bf16_t;
typedef short bf16x8 __attribute__((ext_vector_type(8)));
typedef float f32x4 __attribute__((ext_vector_type(4)));
typedef unsigned u32x4 __attribute__((ext_vector_type(4)));
constexpr int BM = 256, BK = 64, HALF = 128, HTB = HALF * BK * 2  , STAGE_BYTES = 8 * HTB, NXCD = 8, WGM = 8;

__host__ __device__ __forceinline__ int lds_byte(int r, int c) { const int st = (r >> 4) * 2 + (c >> 5), rr = r & 15, cc = c & 31, ob = rr * 64 + cc * 2; return st * 1024 + (ob ^ (((ob >> 9) & 1) << 5)); }
__host__ __device__ __forceinline__ void stage_rc(int b, int& R, int& C) { const int st = b / 1024, sb = b % 1024, swz = sb ^ (((sb >> 9) & 1) << 5); R = (st >> 1) * 16 + swz / 64; C = (st & 1) * 32 + (swz % 64) / 2; }
__host__ __device__ __forceinline__ int perm32(int rho) { const int n = rho >> 4, i = rho & 15; return 8 * (i >> 2) + 4 * n + (i & 3); }

struct Unit { int pm, pn; };
struct Gemm { const bf16_t* A; const bf16_t* Bt; int M, N, K; };

struct StaticOrder {
    int nM, nN, nwg, G, c;
    __host__ __device__ void init(int M, int N, int G_, int c_) { nM = M / BM; nN = N / BM; nwg = nM * nN; G = G_; c = c_; }
    __host__ __device__ bool next(int i, Unit& u) const {
        const long L = (long)i * G + c; if (L >= nwg) return false;
        int wgid = (int)L; { const int q = nwg / NXCD, r = nwg % NXCD, xcd = wgid % NXCD, off = wgid / NXCD; wgid = (xcd < r ? xcd * (q + 1) : r * (q + 1) + (xcd - r) * q) + off; }
        const int nig = WGM * nN, gid = wgid / nig, fm = gid * WGM, gsz = (nM - fm) < WGM ? (nM - fm) : WGM;
        u.pm = fm + ((wgid % nig) % gsz); u.pn = (wgid % nig) / gsz; return true;
    }
    __device__ __forceinline__ void a_ready(const Unit&) const {}
    __device__ __forceinline__ void done(const Unit&) const {}
};

__device__ __forceinline__ unsigned cvt_pk_bf16(float lo, float hi) { unsigned r; asm volatile("v_cvt_pk_bf16_f32 %0, %1, %2" : "=v"(r) : "v"(lo), "v"(hi)); return r; }
typedef float f32x2 __attribute__((ext_vector_type(2)));
__device__ __forceinline__ f32x2 gelu_pk(f32x2 v) {
    const f32x2 av = __builtin_elementwise_abs(v), d = av * 0.2316418882f + 1.0f;
    f32x2 t; t.x = __builtin_amdgcn_rcpf(d.x); t.y = __builtin_amdgcn_rcpf(d.y);
    f32x2 q = t * 0.5307027145f + (-0.7265760135f); q = q * t + 0.7107068705f; q = q * t + (-0.142248368f); q = q * t + 0.127414796f; q = q * t;
    const f32x2 s = (v * v) * (-0.72134752044f);
    f32x2 e; e.x = __builtin_amdgcn_exp2f(s.x); e.y = __builtin_amdgcn_exp2f(s.y);
    const f32x2 m = v * (q * e), r = v - m;
    f32x2 o; o.x = v.x < 0.f ? m.x : r.x; o.y = v.y < 0.f ? m.y : r.y; return o;
}

template <int ACT  > struct EpiBf16 {
    static constexpr bool PERM = true, AFTER_DRAIN = false; static_assert(ACT == 0 || ACT == 1, "EpiBf16: ACT is 0 (none) or 1 (gelu_pk)");
    bf16_t* O; int ldc; const float* bias; int split_cols; size_t split_stride; float scale0;
    __device__ __forceinline__ void operator()(const f32x4 (&acc)[2][2][4][2], const Unit& u, int wr, int wc, int fr, int fq) const {
        const int row0 = u.pm * BM + wr * 64 + fr; int colt = u.pn * BM; bf16_t* base = O;
        float sc = 1.f; if (split_cols) { const int t = colt / split_cols; base += (size_t)t * split_stride; colt -= t * split_cols; if (t == 0) sc = scale0; }
        const int col0 = colt + wc * 32 + 8 * fq, bcol0 = u.pn * BM + wc * 32 + 8 * fq;
        f32x4 bv[2][2];
#pragma unroll
        for (int bj = 0; bj < 2; ++bj)
#pragma unroll
            for (int n = 0; n < 2; ++n) bv[bj][n] = bias ? *(const f32x4*)(bias + bcol0 + bj * HALF + 4 * n) : (f32x4){0.f, 0.f, 0.f, 0.f};
#pragma unroll
        for (int ai = 0; ai < 2; ++ai)
#pragma unroll
            for (int m = 0; m < 4; ++m) { bf16_t* rowp = base + (size_t)(row0 + ai * HALF + m * 16) * ldc + col0;
#pragma unroll
                for (int bj = 0; bj < 2; ++bj) { f32x4 v0 = acc[ai][bj][m][0] + bv[bj][0], v1 = acc[ai][bj][m][1] + bv[bj][1];
                    if (ACT == 1) { f32x2 a = gelu_pk((f32x2){v0[0], v0[1]}), b = gelu_pk((f32x2){v0[2], v0[3]}), c = gelu_pk((f32x2){v1[0], v1[1]}), d = gelu_pk((f32x2){v1[2], v1[3]});
                        v0 = (f32x4){a.x, a.y, b.x, b.y}; v1 = (f32x4){c.x, c.y, d.x, d.y}; }
                    v0 = v0 * sc; v1 = v1 * sc; u32x4 w; w.x = cvt_pk_bf16(v0[0], v0[1]); w.y = cvt_pk_bf16(v0[2], v0[3]); w.z = cvt_pk_bf16(v1[0], v1[1]); w.w = cvt_pk_bf16(v1[2], v1[3]);
                    *(u32x4*)(rowp + bj * HALF) = w; } }
    }
};

template <class Epi, class Sched, bool ALIGN_EPI = false, bool SP2 = false>
__device__ __forceinline__ void gemm_phase(PG8_LAS unsigned char* lds, const Gemm g, const Sched& S, const Epi& E) {
    int tid_ = threadIdx.x; asm volatile("" : "+v"(tid_));
    const int tid = tid_, wid = __builtin_amdgcn_readfirstlane(tid >> 6), lane = tid & 63, wr = wid >> 2, wc = wid & 3, fr = lane & 15, fq = lane >> 4;
    const int K = g.K, nt = K / BK;
    unsigned voffA[2], voffB[2];
#pragma unroll
    for (int i = 0; i < 2; ++i) { int R, C; stage_rc(tid * 16 + i * 8192, R, C); const int Rb = Epi::PERM ? ((R & ~31) + perm32(R & 31)) : R;
        voffA[i] = (unsigned)(R * K + C) * 2u; voffB[i] = (unsigned)(Rb * K + C) * 2u; }
    const size_t kstep = (size_t)(BK * 2);
    const size_t hstep = (size_t)HALF * K * 2;
    const size_t tstep = 2 * hstep;
    const unsigned ldsw = (unsigned)wid * 1024u;
    const int aoff = lds_byte(wr * 64 + fr, fq * 8), boff = lds_byte(wc * 32 + fr, fq * 8);
#define PG8_SA(b, h) (((b) * 2 + (h)) * HTB)
#define PG8_SB(b, h) ((4 + (b) * 2 + (h)) * HTB)
#define PG8_STAGE(bufoff, gbase, voff) do { _Pragma("unroll") for (int _i = 0; _i < 2; ++_i) \
        __builtin_amdgcn_global_load_lds((const unsigned*)((const char*)(gbase) + (voff)[_i]), (PG8_LAS unsigned*)(lds + (bufoff) + ldsw + _i * 8192), 16, 0, 0); } while (0)
#define PG8_LDA(dst, b, h) do { _Pragma("unroll") for (int m = 0; m < 4; ++m) _Pragma("unroll") for (int k = 0; k < 2; ++k) dst[m][k] = *(const PG8_LAS bf16x8*)(lds + PG8_SA(b, h) + aoff + m * 2048 + k * 1024); } while (0)
#define PG8_LDB(dst, b, h) do { _Pragma("unroll") for (int n = 0; n < 2; ++n) _Pragma("unroll") for (int k = 0; k < 2; ++k) dst[n][k] = *(const PG8_LAS bf16x8*)(lds + PG8_SB(b, h) + boff + n * 2048 + k * 1024); } while (0)
#define PG8_MMA(ai, bj, At, Bt) do { __builtin_amdgcn_s_setprio(1); _Pragma("unroll") for (int m = 0; m < 4; ++m) _Pragma("unroll") for (int n = 0; n < 2; ++n) _Pragma("unroll") for (int k = 0; k < 2; ++k) \
        acc[ai][bj][m][n] = __builtin_amdgcn_mfma_f32_16x16x32_bf16(Bt[n][k], At[m][k], acc[ai][bj][m][n], 0, 0, 0); __builtin_amdgcn_s_setprio(0); } while (0)
#define PG8_WAIT_V(n) asm volatile("s_waitcnt vmcnt(" #n ")" ::: "memory")
#define PG8_WAIT_L(n) asm volatile("s_waitcnt lgkmcnt(" #n ")" ::: "memory")
#define PG8_BAR __builtin_amdgcn_s_barrier()
#define PG8_SCHED __builtin_amdgcn_sched_barrier(0)
    Unit cur, nxt; int ui = 0;
    if (!S.next(0, cur)) return;
    f32x4 acc[2][2][4][2];
#pragma unroll
    for (int a = 0; a < 2; ++a)
#pragma unroll
        for (int b = 0; b < 2; ++b)
#pragma unroll
            for (int m = 0; m < 4; ++m)
#pragma unroll
                for (int n = 0; n < 2; ++n) acc[a][b][m][n] = (f32x4){0.f, 0.f, 0.f, 0.f};
    bf16x8 At[4][2], B0[2][2], B1[2][2];
    const char* cA = (const char*)g.A + (size_t)cur.pm * tstep; const char* cB = (const char*)g.Bt + (size_t)cur.pn * tstep;
    S.a_ready(cur);
    if constexpr (SP2) {
        PG8_STAGE(PG8_SB(0, 0), cB, voffB); PG8_STAGE(PG8_SB(0, 1), cB + hstep, voffB); PG8_STAGE(PG8_SA(0, 0), cA, voffA); PG8_STAGE(PG8_SA(0, 1), cA + hstep, voffA);
        if (wr == 1) PG8_BAR;
        PG8_WAIT_V(2); PG8_BAR;
        PG8_STAGE(PG8_SB(1, 0), cB + kstep, voffB); PG8_STAGE(PG8_SA(1, 0), cA + kstep, voffA); PG8_STAGE(PG8_SB(1, 1), cB + hstep + kstep, voffB);
        PG8_WAIT_V(6); PG8_BAR;
    } else {
        PG8_STAGE(PG8_SB(0, 0), cB, voffB); PG8_STAGE(PG8_SA(0, 0), cA, voffA); PG8_STAGE(PG8_SB(0, 1), cB + hstep, voffB); PG8_STAGE(PG8_SA(0, 1), cA + hstep, voffA);
        if (wr == 1) PG8_BAR;
        PG8_WAIT_V(4); PG8_BAR;
        PG8_STAGE(PG8_SB(1, 0), cB + kstep, voffB); PG8_STAGE(PG8_SA(1, 0), cA + kstep, voffA); PG8_STAGE(PG8_SB(1, 1), cB + hstep + kstep, voffB);
        PG8_WAIT_V(6); PG8_BAR;
    }
    for (;;) {
        const bool has_next = S.next(ui + 1, nxt);
        const char* nA = has_next ? (const char*)g.A + (size_t)nxt.pm * tstep : cA; const char* nB = has_next ? (const char*)g.Bt + (size_t)nxt.pn * tstep : cB;
        for (int t = 0; t < nt; t += 2) {
            const bool last = (t == nt - 2);
            const char* a1 = cA + (size_t)(t + 1) * kstep;
            const char* a2 = last ? nA : cA + (size_t)(t + 2) * kstep; const char* b2 = last ? nB : cB + (size_t)(t + 2) * kstep;
            const char* a3 = a2 + kstep; const char* b3 = b2 + kstep;
            if (last && has_next) S.a_ready(nxt);
            if constexpr (SP2) {
            PG8_LDB(B0, 0, 0); PG8_LDB(B1, 0, 1); PG8_SCHED; PG8_LDA(At, 0, 0); PG8_STAGE(PG8_SA(1, 1), a1 + hstep, voffA);
            PG8_WAIT_V(8); PG8_WAIT_L(0); PG8_BAR; PG8_MMA(0, 0, At, B0); PG8_MMA(0, 1, At, B1); PG8_BAR; PG8_SCHED;
            PG8_LDA(At, 0, 1); PG8_STAGE(PG8_SB(0, 0), b2, voffB); PG8_STAGE(PG8_SB(0, 1), b2 + hstep, voffB); PG8_STAGE(PG8_SA(0, 0), a2, voffA);
            PG8_WAIT_V(8); PG8_WAIT_L(0); PG8_BAR; PG8_MMA(1, 0, At, B0); PG8_MMA(1, 1, At, B1); PG8_BAR; PG8_SCHED;
            PG8_LDB(B0, 1, 0); PG8_LDB(B1, 1, 1); PG8_SCHED; PG8_LDA(At, 1, 0); PG8_STAGE(PG8_SA(0, 1), a2 + hstep, voffA);
            PG8_WAIT_V(8); PG8_WAIT_L(0); PG8_BAR; PG8_MMA(0, 0, At, B0); PG8_MMA(0, 1, At, B1); PG8_BAR; PG8_SCHED;
            PG8_LDA(At, 1, 1); PG8_STAGE(PG8_SB(1, 0), b3, voffB); PG8_STAGE(PG8_SB(1, 1), b3 + hstep, voffB); PG8_STAGE(PG8_SA(1, 0), a3, voffA);
            PG8_WAIT_V(8); PG8_WAIT_L(0); PG8_BAR; PG8_MMA(1, 0, At, B0); PG8_MMA(1, 1, At, B1); PG8_BAR; PG8_SCHED;
            } else {
            PG8_LDB(B0, 0, 0); PG8_SCHED; PG8_LDA(At, 0, 0); PG8_STAGE(PG8_SA(1, 1), a1 + hstep, voffA);
            PG8_WAIT_L(8); PG8_BAR; PG8_WAIT_L(0); PG8_MMA(0, 0, At, B0); PG8_BAR; PG8_SCHED;
            PG8_LDB(B1, 0, 1); PG8_STAGE(PG8_SB(0, 0), b2, voffB);
            PG8_BAR; PG8_WAIT_L(0); PG8_MMA(0, 1, At, B1); PG8_BAR;
            PG8_LDA(At, 0, 1); PG8_STAGE(PG8_SA(0, 0), a2, voffA);
            PG8_BAR; PG8_WAIT_L(0); PG8_MMA(1, 0, At, B0); PG8_BAR; PG8_SCHED;
            PG8_STAGE(PG8_SB(0, 1), b2 + hstep, voffB);
            PG8_WAIT_V(6); PG8_BAR; PG8_MMA(1, 1, At, B1); PG8_BAR;
            PG8_LDB(B0, 1, 0); PG8_SCHED; PG8_LDA(At, 1, 0); PG8_STAGE(PG8_SA(0, 1), a2 + hstep, voffA);
            PG8_WAIT_L(8); PG8_BAR; PG8_WAIT_L(0); PG8_MMA(0, 0, At, B0); PG8_BAR; PG8_SCHED;
            PG8_LDB(B1, 1, 1); PG8_STAGE(PG8_SB(1, 0), b3, voffB);
            PG8_BAR; PG8_WAIT_L(0); PG8_MMA(0, 1, At, B1); PG8_BAR;
            PG8_LDA(At, 1, 1); PG8_STAGE(PG8_SA(1, 0), a3, voffA);
            PG8_BAR; PG8_WAIT_L(0); PG8_MMA(1, 0, At, B0); PG8_BAR; PG8_SCHED;
            PG8_STAGE(PG8_SB(1, 1), b3 + hstep, voffB);
            PG8_WAIT_V(6); PG8_BAR; PG8_MMA(1, 1, At, B1); PG8_BAR;
            }
        }
        if constexpr (ALIGN_EPI) { if (wr == 0) PG8_BAR; }
        if constexpr (!Epi::AFTER_DRAIN) { E(acc, cur, wr, wc, fr, fq); S.done(cur); }
        if (!has_next) break;
#pragma unroll
        for (int a = 0; a < 2; ++a)
#pragma unroll
            for (int b = 0; b < 2; ++b)
#pragma unroll
                for (int m = 0; m < 4; ++m)
#pragma unroll
                    for (int n = 0; n < 2; ++n) acc[a][b][m][n] = (f32x4){0.f, 0.f, 0.f, 0.f};
        cur = nxt; cA = nA; cB = nB; ++ui;
        if constexpr (ALIGN_EPI) { if (wr == 1) PG8_BAR; }
    }
    PG8_WAIT_V(0);
    if constexpr (!ALIGN_EPI) { if (wr == 0) PG8_BAR; }
    PG8_BAR;
    if constexpr (Epi::AFTER_DRAIN) { E.fused(acc, cur, wr, wc, fr, fq, lds, wid, lane); S.done(cur); }
#undef PG8_SA
#undef PG8_SB
#undef PG8_STAGE
#undef PG8_LDA
#undef PG8_LDB
#undef PG8_MMA
#undef PG8_WAIT_V
#undef PG8_WAIT_L
#undef PG8_BAR
#undef PG8_SCHED
}
}

constexpr int BATCH = 8, SEQ = 2048, DM = 2048, MROWS = BATCH * SEQ, DIN = 7680, DEPTH = 2;
constexpr int C_AQ = 0, C_AK = 512, C_AV = 1024, C_AG = 1536, C_BQ = 2048, C_BK = 3072, C_BV = 4096, C_BG = 5120, C_CU = 6144, C_CGLU = 6656, C_CG = 7168;
constexpr int Y_A = 0, Y_B = 512, Y_C = 1536;
constexpr int DC = 512, CONVW = 31;
constexpr float LN_EPS = 1e-5f;
constexpr float ALPHA = 1.41421356237309515f;
constexpr int NWAVES = 8;
constexpr int LDS_BYTES = 147456;

constexpr size_t MiB = 1u << 20;
constexpr size_t WS_CTL = 0, CTL_ZERO_BYTES = 64 * 1024;
constexpr size_t WS_TAB = 1 * MiB;
constexpr size_t TAB_BIASA = 0, TAB_BIASB = 32 * 1024, TAB_LAM = 64 * 1024;
constexpr size_t WS_WIN = 2 * MiB;
constexpr size_t WS_WOUT = 62 * MiB;
constexpr size_t WS_WPW = 78 * MiB;
constexpr size_t WS_XB = 80 * MiB;
constexpr size_t WS_Y = 144 * MiB;
constexpr size_t WS_PROJ = 208 * MiB;
constexpr size_t WS_END = 448 * MiB;

#define GAS __attribute__((address_space(1)))
#define LAS __attribute__((address_space(3)))
typedef unsigned short bf16;
typedef unsigned v4u __attribute__((ext_vector_type(4)));
typedef unsigned v2u __attribute__((ext_vector_type(2)));
typedef float f32x4 __attribute__((ext_vector_type(4)));
#define LDS_WAIT() asm volatile("s_waitcnt lgkmcnt(0)" ::: "memory")
#define VM_WAIT() asm volatile("s_waitcnt vmcnt(0)" ::: "memory")

__device__ __forceinline__ unsigned f2bf(float f) { unsigned u = __builtin_bit_cast(unsigned, f); return (u + 0x7fffu + ((u >> 16) & 1u)) >> 16; }
__device__ __forceinline__ unsigned pk2(float lo, float hi) { return f2bf(lo) | (f2bf(hi) << 16); }
__device__ __forceinline__ float bflo(unsigned u) { return __uint_as_float(u << 16); }
__device__ __forceinline__ float bfhi(unsigned u) { return __uint_as_float(u & 0xffff0000u); }
__device__ __forceinline__ float wave_sum(float v) {
#pragma unroll
    for (int o = 1; o < 64; o <<= 1) v += __shfl_xor(v, o);
    return v;
}
__device__ __forceinline__ float wave_max(float v) {
#pragma unroll
    for (int o = 1; o < 64; o <<= 1) v = fmaxf(v, __shfl_xor(v, o));
    return v;
}
__device__ __forceinline__ float dot8(v4u a, v4u b, float s) {
    s += bflo(a.x) * bflo(b.x); s += bfhi(a.x) * bfhi(b.x); s += bflo(a.y) * bflo(b.y); s += bfhi(a.y) * bfhi(b.y);
    s += bflo(a.z) * bflo(b.z); s += bfhi(a.z) * bfhi(b.z); s += bflo(a.w) * bflo(b.w); s += bfhi(a.w) * bfhi(b.w);
    return s;
}
__device__ __forceinline__ float silu_f(float x) { return x / (1.f + __expf(-x)); }
__device__ __forceinline__ float sigmoid_f(float x) { return 1.f / (1.f + __expf(-x)); }
__device__ __forceinline__ int t5_bucket(int d) {
    if (d < 16) return d;
    int v = 16 + (int)(logf((float)d * (1.f / 16.f)) / 4.852030263919617f * 16.f);
    return v < 31 ? v : 31;
}
__host__ __device__ __forceinline__ float lam_init_of(int layer) { return layer == 0 ? 0.2f : 0.35550906759f; }

struct EpiResid {
    static constexpr bool PERM = false, AFTER_DRAIN = false;
    const float* res; float* out; int ldc; float alpha;
    __device__ __forceinline__ void operator()(const pg8::f32x4 (&acc)[2][2][4][2], const pg8::Unit& u, int wr, int wc, int fr, int fq) const {
        const int row0 = u.pm * pg8::BM + wr * 64 + fr, col0 = u.pn * pg8::BM + wc * 32 + 4 * fq;
#pragma unroll
        for (int ai = 0; ai < 2; ++ai)
#pragma unroll
            for (int m = 0; m < 4; ++m) { const size_t off = (size_t)(row0 + ai * pg8::HALF + m * 16) * ldc + col0;
                pg8::f32x4 r[2][2];
#pragma unroll
                for (int bj = 0; bj < 2; ++bj)
#pragma unroll
                    for (int n = 0; n < 2; ++n) r[bj][n] = *(const pg8::f32x4*)(res + off + bj * pg8::HALF + n * 16);
#pragma unroll
                for (int bj = 0; bj < 2; ++bj)
#pragma unroll
                    for (int n = 0; n < 2; ++n) *(pg8::f32x4*)(out + off + bj * pg8::HALF + n * 16) = r[bj][n] * alpha + acc[ai][bj][m][n];
                asm volatile("" ::: "memory"); }
    }
};

struct Frame {
    LAS unsigned char* lds;
    int G;
    const float *x, *w_in, *diff_lambda, *head_gain, *conv_dw, *conv_b, *conv_ln_g, *conv_ln_b, *conv_pw, *w_out, *ln_g, *ln_b, *rel_bias;
    float* out;
    bf16 *win_t, *wout_t, *wpw_t, *xb, *ymix, *proj;
    float *biasA, *biasB, *lamv;
};

#define PHASE_IDS() int tid_ = threadIdx.x; asm volatile("" : "+v"(tid_)); const int tid = tid_, lane = tid & 63, wave = __builtin_amdgcn_readfirstlane(tid >> 6); (void)tid; (void)lane; (void)wave
__device__ __forceinline__ void p0_transpose_item(const float* W, int K, int N, bf16* WT, LAS float* scr, int item, int lane) {
    const int nblk = N / 32, kb = item / nblk, nb = item % nblk, k0 = 64 * kb, n0 = 32 * nb;
#pragma unroll 8
    for (int i = 0; i < 32; ++i) { const int kk = 2 * i + (lane >> 5); scr[kk * 33 + (lane & 31)] = W[(size_t)(k0 + kk) * N + n0 + (lane & 31)]; }
    LDS_WAIT(); asm volatile("" ::: "memory");
    const int c = lane & 7;
#pragma unroll
    for (int j = 0; j < 4; ++j) { const int n = (lane >> 3) + 8 * j; const LAS float* s = scr + (8 * c) * 33 + n;
        v4u o; o.x = pk2(s[0 * 33], s[1 * 33]); o.y = pk2(s[2 * 33], s[3 * 33]); o.z = pk2(s[4 * 33], s[5 * 33]); o.w = pk2(s[6 * 33], s[7 * 33]);
        *(GAS v4u*)(WT + (size_t)(n0 + n) * K + k0 + 8 * c) = o; }
    LDS_WAIT(); asm volatile("" ::: "memory");
}

__device__ __forceinline__ void p0_prologue(Frame& F) {
    PHASE_IDS();
    LAS float* scr = (LAS float*)(F.lds + wave * 16384);
    const int gw = blockIdx.x * NWAVES + wave, NGW = F.G * NWAVES;
    constexpr int I_IN = (DM / 64) * (DIN / 32), I_OUT = (DM / 64) * (DM / 32), I_PW = (DC / 64) * (DC / 32);
    constexpr int NITEMS = DEPTH * (I_IN + I_OUT + I_PW);
    for (int it = gw; it < NITEMS; it += NGW) {
        int r = it;
        if (r < DEPTH * I_IN) { const int l = r / I_IN; r -= l * I_IN; p0_transpose_item(F.w_in + (size_t)l * DM * DIN, DM, DIN, F.win_t + (size_t)l * DIN * DM, scr, r, lane); continue; }
        r -= DEPTH * I_IN;
        if (r < DEPTH * I_OUT) { const int l = r / I_OUT; r -= l * I_OUT; p0_transpose_item(F.w_out + (size_t)l * DM * DM, DM, DM, F.wout_t + (size_t)l * DM * DM, scr, r, lane); continue; }
        r -= DEPTH * I_OUT;
        { const int l = r / I_PW; r -= l * I_PW; p0_transpose_item(F.conv_pw + (size_t)l * DC * DC, DC, DC, F.wpw_t + (size_t)l * DC * DC, scr, r, lane); }
    }
    { const size_t n8 = (size_t)MROWS * DM / 8;
      for (size_t i = (size_t)gw * 64 + lane; i < n8; i += (size_t)NGW * 64) {
          const f32x4 a = *(const GAS f32x4*)(F.x + i * 8), b = *(const GAS f32x4*)(F.x + i * 8 + 4);
          v4u o; o.x = pk2(a.x, a.y); o.y = pk2(a.z, a.w); o.z = pk2(b.x, b.y); o.w = pk2(b.z, b.w);
          *(GAS v4u*)(F.xb + i * 8) = o; } }
    { const int gt = blockIdx.x * (NWAVES * 64) + tid, NT = F.G * NWAVES * 64;
      for (int i = gt; i < 4 * 2048; i += NT) { const int h = i >> 11, d = i & 2047; F.biasA[i] = F.rel_bias[t5_bucket(d) * 12 + h]; }
      for (int i = gt; i < 3 * 8 * 132; i += NT) { const int p = i / (8 * 132), h = (i / 132) % 8, j = i % 132; const int dil = p == 0 ? 1 : (p == 1 ? 4 : 16);
          F.biasB[i] = (j <= 128) ? F.rel_bias[t5_bucket(j * dil) * 12 + 4 + h] : 0.f; }
      if (gt < DEPTH) { const float* lv = F.diff_lambda + gt * 4 * 64; float s0 = 0.f, s1 = 0.f;
          for (int i = 0; i < 64; ++i) { s0 += lv[i] * lv[64 + i]; s1 += lv[128 + i] * lv[192 + i]; }
          F.lamv[gt] = expf(s0) - expf(s1) + lam_init_of(gt); } }
}

__device__ __forceinline__ void naive_mixer_a(Frame& F, int layer) {
    PHASE_IDS();
    LAS float* sc = (LAS float*)(F.lds) + wave * 4096;
    const float lam = F.lamv[layer], li = lam_init_of(layer);
    const int gw = blockIdx.x * NWAVES + wave, NGW = F.G * NWAVES;
    for (int item = gw; item < MROWS * 4; item += NGW) {
        const int h = item & 3, bt = item >> 2, t = bt & (SEQ - 1), b = bt >> 11;
        const bf16* base = F.proj + (size_t)(b * SEQ) * DIN;
        const bf16* qp = base + (size_t)t * DIN + C_AQ + h * 128;
        v4u q[16];
#pragma unroll
        for (int i = 0; i < 16; ++i) q[i] = *(const GAS v4u*)(qp + i * 8);
        float m0 = -INFINITY, m1 = -INFINITY;
        for (int k = lane; k <= t; k += 64) {
            const bf16* kp = base + (size_t)k * DIN + C_AK + h * 128;
            float s0 = 0.f, s1 = 0.f;
#pragma unroll
            for (int i = 0; i < 8; ++i) s0 = dot8(q[i], *(const GAS v4u*)(kp + i * 8), s0);
#pragma unroll
            for (int i = 8; i < 16; ++i) s1 = dot8(q[i], *(const GAS v4u*)(kp + i * 8), s1);
            const float bias = F.biasA[h * 2048 + (t - k)];
            s0 = s0 * 0.125f + bias; s1 = s1 * 0.125f + bias;
            sc[k] = s0; sc[2048 + k] = s1; m0 = fmaxf(m0, s0); m1 = fmaxf(m1, s1);
        }
        m0 = wave_max(m0); m1 = wave_max(m1);
        float l0 = 0.f, l1 = 0.f;
        for (int k = lane; k <= t; k += 64) { const float p0 = __expf(sc[k] - m0), p1 = __expf(sc[2048 + k] - m1); sc[k] = p0; sc[2048 + k] = p1; l0 += p0; l1 += p1; }
        l0 = wave_sum(l0); l1 = wave_sum(l1);
        const float i0 = 1.f / l0, i1 = lam / l1;
        for (int k = lane; k <= t; k += 64) sc[k] = sc[k] * i0 - sc[2048 + k] * i1;
        LDS_WAIT(); asm volatile("" ::: "memory");
        float a0 = 0.f, a1 = 0.f;
        const bf16* vp = base + C_AV + h * 128 + 2 * lane;
        for (int k = 0; k <= t; ++k) { const float a = sc[k]; const unsigned v = *(const GAS unsigned*)(vp + (size_t)k * DIN); a0 += a * bflo(v); a1 += a * bfhi(v); }
        const float ss = wave_sum(a0 * a0 + a1 * a1);
        const float r = rsqrtf(ss * (1.f / 128.f) + LN_EPS) * (1.f - li);
        const float g0 = F.head_gain[layer * 128 + 2 * lane], g1 = F.head_gain[layer * 128 + 2 * lane + 1];
        const unsigned ag = *(const GAS unsigned*)(base + (size_t)t * DIN + C_AG + h * 128 + 2 * lane);
        const float o0 = a0 * r * g0 * silu_f(bflo(ag)), o1 = a1 * r * g1 * silu_f(bfhi(ag));
        *(GAS unsigned*)(F.ymix + (size_t)(b * SEQ + t) * DM + Y_A + h * 128 + 2 * lane) = pk2(o0, o1);
        LDS_WAIT(); asm volatile("" ::: "memory");
    }
}

__device__ __forceinline__ void naive_mixer_b(Frame& F, int layer) {
    PHASE_IDS();
    LAS float* sc = (LAS float*)(F.lds) + wave * 512;
    const int gw = blockIdx.x * NWAVES + wave, NGW = F.G * NWAVES;
    const float scale = 0.08838834764831845f;
    for (int item = gw; item < MROWS * 8; item += NGW) {
        const int h = item & 7, bt = item >> 3, t = bt & (SEQ - 1), b = bt >> 11;
        const bf16* base = F.proj + (size_t)(b * SEQ) * DIN;
        const bf16* qp = base + (size_t)t * DIN + C_BQ + h * 128;
        v4u q[16];
#pragma unroll
        for (int i = 0; i < 16; ++i) q[i] = *(const GAS v4u*)(qp + i * 8);
        float m = -INFINITY;
#pragma unroll
        for (int p = 0; p < 3; ++p) { const int dil = p == 0 ? 1 : (p == 1 ? 4 : 16);
            for (int j = lane; j <= 128; j += 64) { const int tk = t - j * dil; float s = -INFINITY;
                if (tk >= 0) { const bf16* kp = base + (size_t)tk * DIN + C_BK + h * 128; s = 0.f;
#pragma unroll
                    for (int i = 0; i < 16; ++i) s = dot8(q[i], *(const GAS v4u*)(kp + i * 8), s);
                    s = s * scale + F.biasB[(p * 8 + h) * 132 + j]; }
                sc[p * 132 + j] = s; m = fmaxf(m, s); } }
        m = wave_max(m);
        float l = 0.f;
#pragma unroll
        for (int p = 0; p < 3; ++p) for (int j = lane; j <= 128; j += 64) { const float e = __expf(sc[p * 132 + j] - m); sc[p * 132 + j] = e; l += e; }
        l = wave_sum(l);
        LDS_WAIT(); asm volatile("" ::: "memory");
        float a0 = 0.f, a1 = 0.f;
        const bf16* vp = base + C_BV + h * 128 + 2 * lane;
#pragma unroll
        for (int p = 0; p < 3; ++p) { const int dil = p == 0 ? 1 : (p == 1 ? 4 : 16); int jmax = t / dil; jmax = jmax < 128 ? jmax : 128;
            for (int j = 0; j <= jmax; ++j) { const float a = sc[p * 132 + j]; const unsigned v = *(const GAS unsigned*)(vp + (size_t)(t - j * dil) * DIN); a0 += a * bflo(v); a1 += a * bfhi(v); } }
        const float il = 1.f / l;
        const unsigned bg = *(const GAS unsigned*)(base + (size_t)t * DIN + C_BG + h * 128 + 2 * lane);
        *(GAS unsigned*)(F.ymix + (size_t)(b * SEQ + t) * DM + Y_B + h * 128 + 2 * lane) = pk2(a0 * il * silu_f(bflo(bg)), a1 * il * silu_f(bfhi(bg)));
        LDS_WAIT(); asm volatile("" ::: "memory");
    }
}

__device__ __forceinline__ void naive_mixer_c(Frame& F, int layer) {
    PHASE_IDS();
    LAS float* hb = (LAS float*)(F.lds) + wave * 512;
    const int gw = blockIdx.x * NWAVES + wave, NGW = F.G * NWAVES, c0 = lane * 8;
    const float* dw = F.conv_dw + (size_t)layer * CONVW * DC; const float* pw = F.conv_pw + (size_t)layer * DC * DC;
    for (int item = gw; item < MROWS; item += NGW) {
        const int t = item & (SEQ - 1), b = item >> 11;
        const bf16* base = F.proj + (size_t)(b * SEQ) * DIN;
        float acc[8];
#pragma unroll
        for (int i = 0; i < 8; ++i) acc[i] = F.conv_b[layer * DC + c0 + i];
        for (int j = 0; j < CONVW; ++j) { const int tk = t - (CONVW - 1) + j; if (tk < 0) continue;
            const v4u u = *(const GAS v4u*)(base + (size_t)tk * DIN + C_CU + c0), g = *(const GAS v4u*)(base + (size_t)tk * DIN + C_CGLU + c0);
            const f32x4 w0 = *(const GAS f32x4*)(dw + j * DC + c0), w1 = *(const GAS f32x4*)(dw + j * DC + c0 + 4);
            acc[0] += w0.x * (bflo(u.x) * sigmoid_f(bflo(g.x))); acc[1] += w0.y * (bfhi(u.x) * sigmoid_f(bfhi(g.x)));
            acc[2] += w0.z * (bflo(u.y) * sigmoid_f(bflo(g.y))); acc[3] += w0.w * (bfhi(u.y) * sigmoid_f(bfhi(g.y)));
            acc[4] += w1.x * (bflo(u.z) * sigmoid_f(bflo(g.z))); acc[5] += w1.y * (bfhi(u.z) * sigmoid_f(bfhi(g.z)));
            acc[6] += w1.z * (bflo(u.w) * sigmoid_f(bflo(g.w))); acc[7] += w1.w * (bfhi(u.w) * sigmoid_f(bfhi(g.w))); }
        float s = 0.f;
#pragma unroll
        for (int i = 0; i < 8; ++i) s += acc[i];
        const float mean = wave_sum(s) * (1.f / DC); float s2 = 0.f;
#pragma unroll
        for (int i = 0; i < 8; ++i) { acc[i] -= mean; s2 += acc[i] * acc[i]; }
        const float rstd = rsqrtf(wave_sum(s2) * (1.f / DC) + LN_EPS);
#pragma unroll
        for (int i = 0; i < 8; ++i) { const float hn = acc[i] * rstd * F.conv_ln_g[layer * DC + c0 + i] + F.conv_ln_b[layer * DC + c0 + i]; hb[c0 + i] = silu_f(hn); }
        LDS_WAIT(); asm volatile("" ::: "memory");
        float o[8];
#pragma unroll
        for (int i = 0; i < 8; ++i) o[i] = 0.f;
        for (int c = 0; c < DC; ++c) { const float hv = hb[c]; const f32x4 w0 = *(const GAS f32x4*)(pw + (size_t)c * DC + c0), w1 = *(const GAS f32x4*)(pw + (size_t)c * DC + c0 + 4);
            o[0] += hv * w0.x; o[1] += hv * w0.y; o[2] += hv * w0.z; o[3] += hv * w0.w; o[4] += hv * w1.x; o[5] += hv * w1.y; o[6] += hv * w1.z; o[7] += hv * w1.w; }
        const v4u cg = *(const GAS v4u*)(base + (size_t)t * DIN + C_CG + c0);
        v4u ov; ov.x = pk2(o[0] * silu_f(bflo(cg.x)), o[1] * silu_f(bfhi(cg.x))); ov.y = pk2(o[2] * silu_f(bflo(cg.y)), o[3] * silu_f(bfhi(cg.y)));
        ov.z = pk2(o[4] * silu_f(bflo(cg.z)), o[5] * silu_f(bfhi(cg.z))); ov.w = pk2(o[6] * silu_f(bflo(cg.w)), o[7] * silu_f(bfhi(cg.w)));
        *(GAS v4u*)(F.ymix + (size_t)(b * SEQ + t) * DM + Y_C + c0) = ov;
        LDS_WAIT(); asm volatile("" ::: "memory");
    }
}

__device__ __forceinline__ void ln_phase(Frame& F, int layer, bool write_xb) {
    PHASE_IDS();
    const int gw = blockIdx.x * NWAVES + wave, NGW = F.G * NWAVES;
    const float* g = F.ln_g + layer * DM; const float* bb = F.ln_b + layer * DM;
    for (int row = gw; row < MROWS; row += NGW) {
        GAS f32x4* xr = (GAS f32x4*)(F.out + (size_t)row * DM) + lane;
        f32x4 v[8]; float s = 0.f;
#pragma unroll
        for (int j = 0; j < 8; ++j) { v[j] = xr[64 * j]; s += (v[j].x + v[j].y) + (v[j].z + v[j].w); }
        const float mean = wave_sum(s) * (1.f / DM); float s2 = 0.f;
#pragma unroll
        for (int j = 0; j < 8; ++j) { v[j] = v[j] - mean; s2 += (v[j].x * v[j].x + v[j].y * v[j].y) + (v[j].z * v[j].z + v[j].w * v[j].w); }
        const float rstd = rsqrtf(wave_sum(s2) * (1.f / DM) + LN_EPS);
#pragma unroll
        for (int j = 0; j < 8; ++j) { const int c = 4 * lane + 256 * j; const f32x4 gv = *(const GAS f32x4*)(g + c), bv = *(const GAS f32x4*)(bb + c);
            const f32x4 o = v[j] * rstd * gv + bv; xr[64 * j] = o;
            if (write_xb) { v2u w; w.x = pk2(o.x, o.y); w.y = pk2(o.z, o.w); *(GAS v2u*)(F.xb + (size_t)row * DM + c) = w; } }
    }
}

struct Args { const float* in[13]; float* out; unsigned char* ws; int ph_lo, ph_hi; };
constexpr int N_PHASES = 1 + 4 * DEPTH;
#ifndef MK_ONE_LAUNCH
#define MK_ONE_LAUNCH 1
#endif

__global__ void __launch_bounds__(NWAVES * 64, 2) hymba_fwd(Args args) {
    extern __shared__ __attribute__((aligned(16))) unsigned char lds[];
    Frame F;
    F.lds = (LAS unsigned char*)lds;
    F.G = gridDim.x;
    unsigned char* ws = args.ws;
    F.x = args.in[0]; F.w_in = args.in[1]; F.diff_lambda = args.in[2]; F.head_gain = args.in[3]; F.conv_dw = args.in[4]; F.conv_b = args.in[5];
    F.conv_ln_g = args.in[6]; F.conv_ln_b = args.in[7]; F.conv_pw = args.in[8]; F.w_out = args.in[9]; F.ln_g = args.in[10]; F.ln_b = args.in[11]; F.rel_bias = args.in[12];
    F.out = args.out;
    F.win_t = (bf16*)(ws + WS_WIN); F.wout_t = (bf16*)(ws + WS_WOUT); F.wpw_t = (bf16*)(ws + WS_WPW); F.xb = (bf16*)(ws + WS_XB); F.ymix = (bf16*)(ws + WS_Y); F.proj = (bf16*)(ws + WS_PROJ);
    F.biasA = (float*)(ws + WS_TAB + TAB_BIASA); F.biasB = (float*)(ws + WS_TAB + TAB_BIASB); F.lamv = (float*)(ws + WS_TAB + TAB_LAM);
    const int lo = args.ph_lo, hi = args.ph_hi;
#define IN(k) (lo <= (k) && (k) < hi)
#if MK_ONE_LAUNCH
    cooperative_groups::grid_group grid = cooperative_groups::this_grid();
#define GRID_BAR() grid.sync()
#else
#define GRID_BAR() do {} while (0)
#endif
    if (IN(0)) { p0_prologue(F); if (IN(1)) GRID_BAR(); }
#pragma unroll
    for (int layer = 0; layer < DEPTH; ++layer) {
        const int p = 1 + 4 * layer;
        if (IN(p)) {
            pg8::Gemm g{F.xb, F.win_t + (size_t)layer * DIN * DM, MROWS, DIN, DM}; pg8::StaticOrder S; S.init(MROWS, DIN, F.G, (int)blockIdx.x);
            pg8::EpiBf16<0> E{F.proj, DIN, nullptr, 0, 0, 1.f};
            pg8::gemm_phase<pg8::EpiBf16<0>, pg8::StaticOrder, true, true>(F.lds, g, S, E);
            if (IN(p + 1)) GRID_BAR();
        }
        if (IN(p + 1)) {
            naive_mixer_a(F, layer); __syncthreads(); naive_mixer_b(F, layer); __syncthreads(); naive_mixer_c(F, layer); __syncthreads();
            if (IN(p + 2)) GRID_BAR();
        }
        if (IN(p + 2)) {
            pg8::Gemm g{F.ymix, F.wout_t + (size_t)layer * DM * DM, MROWS, DM, DM}; pg8::StaticOrder S; S.init(MROWS, DM, F.G, (int)blockIdx.x);
            EpiResid E{layer == 0 ? F.x : F.out, F.out, DM, ALPHA};
            pg8::gemm_phase<EpiResid, pg8::StaticOrder, true, true>(F.lds, g, S, E);
            if (IN(p + 3)) GRID_BAR();
        }
        if (IN(p + 3)) {
            ln_phase(F, layer, layer + 1 < DEPTH);
            if (IN(p + 4)) GRID_BAR();
        }
    }
#undef IN
}

extern "C" void kernel_launch(void* const* d_in, const int* in_sizes, int n_in, void* d_out, int out_size, void* d_ws, size_t ws_size, hipStream_t stream) {
    static int grid = 0;
    if (grid == 0) {
        if (n_in != 13 || in_sizes[0] != MROWS * DM || out_size != MROWS * DM || ws_size < WS_END) { fprintf(stderr, "kernel_launch: unexpected shapes (n_in %d, in0 %d, out %d, ws %zu)\n", n_in, n_in > 0 ? in_sizes[0] : -1, out_size, ws_size); grid = -1; return; }
        int dev = 0, cus = 0, per_cu = 0;
        if (hipGetDevice(&dev) != hipSuccess || hipDeviceGetAttribute(&cus, hipDeviceAttributeMultiprocessorCount, dev) != hipSuccess) { grid = -1; return; }
        if (hipFuncSetAttribute((const void*)hymba_fwd, hipFuncAttributeMaxDynamicSharedMemorySize, LDS_BYTES) != hipSuccess) { fprintf(stderr, "kernel_launch: hipFuncSetAttribute failed\n"); grid = -1; return; }
        if (hipOccupancyMaxActiveBlocksPerMultiprocessor(&per_cu, (const void*)hymba_fwd, NWAVES * 64, LDS_BYTES) != hipSuccess || per_cu < 1) { fprintf(stderr, "kernel_launch: occupancy query says %d\n", per_cu); per_cu = 1; }
        (void)hipGetLastError();
        grid = cus;
    }
    if (grid < 0) return;
    Args a{};
    for (int i = 0; i < 13; ++i) a.in[i] = (const float*)d_in[i];
    a.out = (float*)d_out; a.ws = (unsigned char*)d_ws;
#if MK_ONE_LAUNCH
    a.ph_lo = 0; a.ph_hi = N_PHASES;
    void* kargs[] = {&a};
    hipError_t e = hipLaunchCooperativeKernel((const void*)hymba_fwd, dim3(grid), dim3(NWAVES * 64), kargs, LDS_BYTES, stream);
    if (e != hipSuccess) fprintf(stderr, "kernel_launch: cooperative launch failed: %s (grid %d)\n", hipGetErrorString(e), grid);
#else
    for (int ph = 0; ph < N_PHASES; ++ph) {
        a.ph_lo = ph; a.ph_hi = ph + 1;
        hipLaunchKernelGGL(hymba_fwd, dim3(grid), dim3(NWAVES * 64), LDS_BYTES, stream, a);
        const hipError_t le = hipPeekAtLastError();
        if (le != hipSuccess) { fprintf(stderr, "kernel_launch: launch %d failed: %s\n", ph, hipGetErrorName(le)); break; }
    }
#endif
}
```

```cpp
#include <hip/hip_runtime.h>
#include <hip/hip_cooperative_groups.h>
#include <cstdio>
#include <cstdint>
namespace pg8 {
#define PG8_LAS __attribute__((address_space(3)))
typedef unsigned short bf16_t;
typedef short bf16x8 __attribute__((ext_vector_type(8)));
typedef float f32x4 __attribute__((ext_vector_type(4)));
typedef unsigned u32x4 __attribute__((ext_vector_type(4)));
constexpr int BM = 256, BK = 64, HALF = 128, HTB = HALF * BK * 2  , STAGE_BYTES = 8 * HTB, NXCD = 8, WGM = 8;

__host__ __device__ __forceinline__ int lds_byte(int r, int c) { const int st = (r >> 4) * 2 + (c >> 5), rr = r & 15, cc = c & 31, ob = rr * 64 + cc * 2; return st * 1024 + (ob ^ (((ob >> 9) & 1) << 5)); }
__host__ __device__ __forceinline__ void stage_rc(int b, int& R, int& C) { const int st = b / 1024, sb = b % 1024, swz = sb ^ (((sb >> 9) & 1) << 5); R = (st >> 1) * 16 + swz / 64; C = (st & 1) * 32 + (swz % 64) / 2; }
__host__ __device__ __forceinline__ int perm32(int rho) { const int n = rho >> 4, i = rho & 15; return 8 * (i >> 2) + 4 * n + (i & 3); }

struct Unit { int pm, pn; };
struct Gemm { const bf16_t* A; const bf16_t* Bt; int M, N, K; };

struct StaticOrder {
    int nM, nN, nwg, G, c;
    __host__ __device__ void init(int M, int N, int G_, int c_) { nM = M / BM; nN = N / BM; nwg = nM * nN; G = G_; c = c_; }
    __host__ __device__ bool next(int i, Unit& u) const {
        const long L = (long)i * G + c; if (L >= nwg) return false;
        int wgid = (int)L; { const int q = nwg / NXCD, r = nwg % NXCD, xcd = wgid % NXCD, off = wgid / NXCD; wgid = (xcd < r ? xcd * (q + 1) : r * (q + 1) + (xcd - r) * q) + off; }
        const int nig = WGM * nN, gid = wgid / nig, fm = gid * WGM, gsz = (nM - fm) < WGM ? (nM - fm) : WGM;
        u.pm = fm + ((wgid % nig) % gsz); u.pn = (wgid % nig) / gsz; return true;
    }
    __device__ __forceinline__ void a_ready(const Unit&) const {}
    __device__ __forceinline__ void done(const Unit&) const {}
};

__device__ __forceinline__ unsigned cvt_pk_bf16(float lo, float hi) { unsigned r; asm volatile("v_cvt_pk_bf16_f32 %0, %1, %2" : "=v"(r) : "v"(lo), "v"(hi)); return r; }
typedef float f32x2 __attribute__((ext_vector_type(2)));
__device__ __forceinline__ f32x2 gelu_pk(f32x2 v) {
    const f32x2 av = __builtin_elementwise_abs(v), d = av * 0.2316418882f + 1.0f;
    f32x2 t; t.x = __builtin_amdgcn_rcpf(d.x); t.y = __builtin_amdgcn_rcpf(d.y);
    f32x2 q = t * 0.5307027145f + (-0.7265760135f); q = q * t + 0.7107068705f; q = q * t + (-0.142248368f); q = q * t + 0.127414796f; q = q * t;
    const f32x2 s = (v * v) * (-0.72134752044f);
    f32x2 e; e.x = __builtin_amdgcn_exp2f(s.x); e.y = __builtin_amdgcn_exp2f(s.y);
    const f32x2 m = v * (q * e), r = v - m;
    f32x2 o; o.x = v.x < 0.f ? m.x : r.x; o.y = v.y < 0.f ? m.y : r.y; return o;
}

template <int ACT  > struct EpiBf16 {
    static constexpr bool PERM = true, AFTER_DRAIN = false; static_assert(ACT == 0 || ACT == 1, "EpiBf16: ACT is 0 (none) or 1 (gelu_pk)");
    bf16_t* O; int ldc; const float* bias; int split_cols; size_t split_stride; float scale0;
    __device__ __forceinline__ void operator()(const f32x4 (&acc)[2][2][4][2], const Unit& u, int wr, int wc, int fr, int fq) const {
        const int row0 = u.pm * BM + wr * 64 + fr; int colt = u.pn * BM; bf16_t* base = O;
        float sc = 1.f; if (split_cols) { const int t = colt / split_cols; base += (size_t)t * split_stride; colt -= t * split_cols; if (t == 0) sc = scale0; }
        const int col0 = colt + wc * 32 + 8 * fq, bcol0 = u.pn * BM + wc * 32 + 8 * fq;
        f32x4 bv[2][2];
#pragma unroll
        for (int bj = 0; bj < 2; ++bj)
#pragma unroll
            for (int n = 0; n < 2; ++n) bv[bj][n] = bias ? *(const f32x4*)(bias + bcol0 + bj * HALF + 4 * n) : (f32x4){0.f, 0.f, 0.f, 0.f};
#pragma unroll
        for (int ai = 0; ai < 2; ++ai)
#pragma unroll
            for (int m = 0; m < 4; ++m) { bf16_t* rowp = base + (size_t)(row0 + ai * HALF + m * 16) * ldc + col0;
#pragma unroll
                for (int bj = 0; bj < 2; ++bj) { f32x4 v0 = acc[ai][bj][m][0] + bv[bj][0], v1 = acc[ai][bj][m][1] + bv[bj][1];
                    if (ACT == 1) { f32x2 a = gelu_pk((f32x2){v0[0], v0[1]}), b = gelu_pk((f32x2){v0[2], v0[3]}), c = gelu_pk((f32x2){v1[0], v1[1]}), d = gelu_pk((f32x2){v1[2], v1[3]});
                        v0 = (f32x4){a.x, a.y, b.x, b.y}; v1 = (f32x4){c.x, c.y, d.x, d.y}; }
                    v0 = v0 * sc; v1 = v1 * sc; u32x4 w; w.x = cvt_pk_bf16(v0[0], v0[1]); w.y = cvt_pk_bf16(v0[2], v0[3]); w.z = cvt_pk_bf16(v1[0], v1[1]); w.w = cvt_pk_bf16(v1[2], v1[3]);
                    *(u32x4*)(rowp + bj * HALF) = w; } }
    }
};

template <class Epi, class Sched, bool ALIGN_EPI = false, bool SP2 = false>
__device__ __forceinline__ void gemm_phase(PG8_LAS unsigned char* lds, const Gemm g, const Sched& S, const Epi& E) {
    int tid_ = threadIdx.x; asm volatile("" : "+v"(tid_));
    const int tid = tid_, wid = __builtin_amdgcn_readfirstlane(tid >> 6), lane = tid & 63, wr = wid >> 2, wc = wid & 3, fr = lane & 15, fq = lane >> 4;
    const int K = g.K, nt = K / BK;
    unsigned voffA[2], voffB[2];
#pragma unroll
    for (int i = 0; i < 2; ++i) { int R, C; stage_rc(tid * 16 + i * 8192, R, C); const int Rb = Epi::PERM ? ((R & ~31) + perm32(R & 31)) : R;
        voffA[i] = (unsigned)(R * K + C) * 2u; voffB[i] = (unsigned)(Rb * K + C) * 2u; }
    const size_t kstep = (size_t)(BK * 2);
    const size_t hstep = (size_t)HALF * K * 2;
    const size_t tstep = 2 * hstep;
    const unsigned ldsw = (unsigned)wid * 1024u;
    const int aoff = lds_byte(wr * 64 + fr, fq * 8), boff = lds_byte(wc * 32 + fr, fq * 8);
#define PG8_SA(b, h) (((b) * 2 + (h)) * HTB)
#define PG8_SB(b, h) ((4 + (b) * 2 + (h)) * HTB)
#define PG8_STAGE(bufoff, gbase, voff) do { _Pragma("unroll") for (int _i = 0; _i < 2; ++_i) \
        __builtin_amdgcn_global_load_lds((const unsigned*)((const char*)(gbase) + (voff)[_i]), (PG8_LAS unsigned*)(lds + (bufoff) + ldsw + _i * 8192), 16, 0, 0); } while (0)
#define PG8_LDA(dst, b, h) do { _Pragma("unroll") for (int m = 0; m < 4; ++m) _Pragma("unroll") for (int k = 0; k < 2; ++k) dst[m][k] = *(const PG8_LAS bf16x8*)(lds + PG8_SA(b, h) + aoff + m * 2048 + k * 1024); } while (0)
#define PG8_LDB(dst, b, h) do { _Pragma("unroll") for (int n = 0; n < 2; ++n) _Pragma("unroll") for (int k = 0; k < 2; ++k) dst[n][k] = *(const PG8_LAS bf16x8*)(lds + PG8_SB(b, h) + boff + n * 2048 + k * 1024); } while (0)
#define PG8_MMA(ai, bj, At, Bt) do { __builtin_amdgcn_s_setprio(1); _Pragma("unroll") for (int m = 0; m < 4; ++m) _Pragma("unroll") for (int n = 0; n < 2; ++n) _Pragma("unroll") for (int k = 0; k < 2; ++k) \
        acc[ai][bj][m][n] = __builtin_amdgcn_mfma_f32_16x16x32_bf16(Bt[n][k], At[m][k], acc[ai][bj][m][n], 0, 0, 0); __builtin_amdgcn_s_setprio(0); } while (0)
#define PG8_WAIT_V(n) asm volatile("s_waitcnt vmcnt(" #n ")" ::: "memory")
#define PG8_WAIT_L(n) asm volatile("s_waitcnt lgkmcnt(" #n ")" ::: "memory")
#define PG8_BAR __builtin_amdgcn_s_barrier()
#define PG8_SCHED __builtin_amdgcn_sched_barrier(0)
    Unit cur, nxt; int ui = 0;
    if (!S.next(0, cur)) return;
    f32x4 acc[2][2][4][2];
#pragma unroll
    for (int a = 0; a < 2; ++a)
#pragma unroll
        for (int b = 0; b < 2; ++b)
#pragma unroll
            for (int m = 0; m < 4; ++m)
#pragma unroll
                for (int n = 0; n < 2; ++n) acc[a][b][m][n] = (f32x4){0.f, 0.f, 0.f, 0.f};
    bf16x8 At[4][2], B0[2][2], B1[2][2];
    const char* cA = (const char*)g.A + (size_t)cur.pm * tstep; const char* cB = (const char*)g.Bt + (size_t)cur.pn * tstep;
    S.a_ready(cur);
    if constexpr (SP2) {
        PG8_STAGE(PG8_SB(0, 0), cB, voffB); PG8_STAGE(PG8_SB(0, 1), cB + hstep, voffB); PG8_STAGE(PG8_SA(0, 0), cA, voffA); PG8_STAGE(PG8_SA(0, 1), cA + hstep, voffA);
        if (wr == 1) PG8_BAR;
        PG8_WAIT_V(2); PG8_BAR;
        PG8_STAGE(PG8_SB(1, 0), cB + kstep, voffB); PG8_STAGE(PG8_SA(1, 0), cA + kstep, voffA); PG8_STAGE(PG8_SB(1, 1), cB + hstep + kstep, voffB);
        PG8_WAIT_V(6); PG8_BAR;
    } else {
        PG8_STAGE(PG8_SB(0, 0), cB, voffB); PG8_STAGE(PG8_SA(0, 0), cA, voffA); PG8_STAGE(PG8_SB(0, 1), cB + hstep, voffB); PG8_STAGE(PG8_SA(0, 1), cA + hstep, voffA);
        if (wr == 1) PG8_BAR;
        PG8_WAIT_V(4); PG8_BAR;
        PG8_STAGE(PG8_SB(1, 0), cB + kstep, voffB); PG8_STAGE(PG8_SA(1, 0), cA + kstep, voffA); PG8_STAGE(PG8_SB(1, 1), cB + hstep + kstep, voffB);
        PG8_WAIT_V(6); PG8_BAR;
    }
    for (;;) {
        const bool has_next = S.next(ui + 1, nxt);
        const char* nA = has_next ? (const char*)g.A + (size_t)nxt.pm * tstep : cA; const char* nB = has_next ? (const char*)g.Bt + (size_t)nxt.pn * tstep : cB;
        for (int t = 0; t < nt; t += 2) {
            const bool last = (t == nt - 2);
            const char* a1 = cA + (size_t)(t + 1) * kstep;
            const char* a2 = last ? nA : cA + (size_t)(t + 2) * kstep; const char* b2 = last ? nB : cB + (size_t)(t + 2) * kstep;
            const char* a3 = a2 + kstep; const char* b3 = b2 + kstep;
            if (last && has_next) S.a_ready(nxt);
            if constexpr (SP2) {
            PG8_LDB(B0, 0, 0); PG8_LDB(B1, 0, 1); PG8_SCHED; PG8_LDA(At, 0, 0); PG8_STAGE(PG8_SA(1, 1), a1 + hstep, voffA);
            PG8_WAIT_V(8); PG8_WAIT_L(0); PG8_BAR; PG8_MMA(0, 0, At, B0); PG8_MMA(0, 1, At, B1); PG8_BAR; PG8_SCHED;
            PG8_LDA(At, 0, 1); PG8_STAGE(PG8_SB(0, 0), b2, voffB); PG8_STAGE(PG8_SB(0, 1), b2 + hstep, voffB); PG8_STAGE(PG8_SA(0, 0), a2, voffA);
            PG8_WAIT_V(8); PG8_WAIT_L(0); PG8_BAR; PG8_MMA(1, 0, At, B0); PG8_MMA(1, 1, At, B1); PG8_BAR; PG8_SCHED;
            PG8_LDB(B0, 1, 0); PG8_LDB(B1, 1, 1); PG8_SCHED; PG8_LDA(At, 1, 0); PG8_STAGE(PG8_SA(0, 1), a2 + hstep, voffA);
            PG8_WAIT_V(8); PG8_WAIT_L(0); PG8_BAR; PG8_MMA(0, 0, At, B0); PG8_MMA(0, 1, At, B1); PG8_BAR; PG8_SCHED;
            PG8_LDA(At, 1, 1); PG8_STAGE(PG8_SB(1, 0), b3, voffB); PG8_STAGE(PG8_SB(1, 1), b3 + hstep, voffB); PG8_STAGE(PG8_SA(1, 0), a3, voffA);
            PG8_WAIT_V(8); PG8_WAIT_L(0); PG8_BAR; PG8_MMA(1, 0, At, B0); PG8_MMA(1, 1, At, B1); PG8_BAR; PG8_SCHED;
            } else {
            PG8_LDB(B0, 0, 0); PG8_SCHED; PG8_LDA(At, 0, 0); PG8_STAGE(PG8_SA(1, 1), a1 + hstep, voffA);
            PG8_WAIT_L(8); PG8_BAR; PG8_WAIT_L(0); PG8_MMA(0, 0, At, B0); PG8_BAR; PG8_SCHED;
            PG8_LDB(B1, 0, 1); PG8_STAGE(PG8_SB(0, 0), b2, voffB);
            PG8_BAR; PG8_WAIT_L(0); PG8_MMA(0, 1, At, B1); PG8_BAR;
            PG8_LDA(At, 0, 1); PG8_STAGE(PG8_SA(0, 0), a2, voffA);
            PG8_BAR; PG8_WAIT_L(0); PG8_MMA(1, 0, At, B0); PG8_BAR; PG8_SCHED;
            PG8_STAGE(PG8_SB(0, 1), b2 + hstep, voffB);
            PG8_WAIT_V(6); PG8_BAR; PG8_MMA(1, 1, At, B1); PG8_BAR;
            PG8_LDB(B0, 1, 0); PG8_SCHED; PG8_LDA(At, 1, 0); PG8_STAGE(PG8_SA(0, 1), a2 + hstep, voffA);
            PG8_WAIT_L(8); PG8_BAR; PG8_WAIT_L(0); PG8_MMA(0, 0, At, B0); PG8_BAR; PG8_SCHED;
            PG8_LDB(B1, 1, 1); PG8_STAGE(PG8_SB(1, 0), b3, voffB);
            PG8_BAR; PG8_WAIT_L(0); PG8_MMA(0, 1, At, B1); PG8_BAR;
            PG8_LDA(At, 1, 1); PG8_STAGE(PG8_SA(1, 0), a3, voffA);
            PG8_BAR; PG8_WAIT_L(0); PG8_MMA(1, 0, At, B0); PG8_BAR; PG8_SCHED;
            PG8_STAGE(PG8_SB(1, 1), b3 + hstep, voffB);
            PG8_WAIT_V(6); PG8_BAR; PG8_MMA(1, 1, At, B1); PG8_BAR;
            }
        }
        if constexpr (ALIGN_EPI) { if (wr == 0) PG8_BAR; }
        if constexpr (!Epi::AFTER_DRAIN) { E(acc, cur, wr, wc, fr, fq); S.done(cur); }
        if (!has_next) break;
#pragma unroll
        for (int a = 0; a < 2; ++a)
#pragma unroll
            for (int b = 0; b < 2; ++b)
#pragma unroll
                for (int m = 0; m < 4; ++m)
#pragma unroll
                    for (int n = 0; n < 2; ++n) acc[a][b][m][n] = (f32x4){0.f, 0.f, 0.f, 0.f};
        cur = nxt; cA = nA; cB = nB; ++ui;
        if constexpr (ALIGN_EPI) { if (wr == 1) PG8_BAR; }
    }
    PG8_WAIT_V(0);
    if constexpr (!ALIGN_EPI) { if (wr == 0) PG8_BAR; }
    PG8_BAR;
    if constexpr (Epi::AFTER_DRAIN) { E.fused(acc, cur, wr, wc, fr, fq, lds, wid, lane); S.done(cur); }
#undef PG8_SA
#undef PG8_SB
#undef PG8_STAGE
#undef PG8_LDA
#undef PG8_LDB
#undef PG8_MMA
#undef PG8_WAIT_V
#undef PG8_WAIT_L
#undef PG8_BAR
#undef PG8_SCHED
}
}

constexpr int BATCH = 8, SEQ = 2048, DM = 2048, MROWS = BATCH * SEQ, DIN = 7680, DEPTH = 2;
constexpr int C_AQ = 0, C_AK = 512, C_AV = 1024, C_AG = 1536, C_BQ = 2048, C_BK = 3072, C_BV = 4096, C_BG = 5120, C_CU = 6144, C_CGLU = 6656, C_CG = 7168;
constexpr int Y_A = 0, Y_B = 512, Y_C = 1536;
constexpr int DC = 512, CONVW = 31;
constexpr float LN_EPS = 1e-5f;
constexpr float ALPHA = 1.41421356237309515f;
constexpr int NWAVES = 8;
constexpr int LDS_BYTES = 163840;

constexpr size_t MiB = 1u << 20;
constexpr size_t WS_CTL = 0, CTL_ZERO_BYTES = 64 * 1024;
constexpr size_t WS_TAB = 1 * MiB;
constexpr size_t TAB_BIASA = 0, TAB_BIASB = 32 * 1024, TAB_LAM = 64 * 1024;
constexpr size_t WS_WIN = 2 * MiB;
constexpr size_t WS_WOUT = 62 * MiB;
constexpr size_t WS_WPW = 78 * MiB;
constexpr size_t WS_XB = 80 * MiB;
constexpr size_t WS_Y = 144 * MiB;
constexpr size_t WS_PROJ = 208 * MiB;
constexpr size_t WS_END = 448 * MiB;

#define GAS __attribute__((address_space(1)))
#define LAS __attribute__((address_space(3)))
typedef unsigned short bf16;
typedef unsigned v4u __attribute__((ext_vector_type(4)));
typedef unsigned v2u __attribute__((ext_vector_type(2)));
typedef float f32x4 __attribute__((ext_vector_type(4)));
#define LDS_WAIT() asm volatile("s_waitcnt lgkmcnt(0)" ::: "memory")
#define VM_WAIT() asm volatile("s_waitcnt vmcnt(0)" ::: "memory")

__device__ __forceinline__ unsigned f2bf(float f) { unsigned u = __builtin_bit_cast(unsigned, f); return (u + 0x7fffu + ((u >> 16) & 1u)) >> 16; }
__device__ __forceinline__ unsigned pk2(float lo, float hi) { return f2bf(lo) | (f2bf(hi) << 16); }
__device__ __forceinline__ float bflo(unsigned u) { return __uint_as_float(u << 16); }
__device__ __forceinline__ float bfhi(unsigned u) { return __uint_as_float(u & 0xffff0000u); }
__device__ __forceinline__ float wave_sum(float v) {
#pragma unroll
    for (int o = 1; o < 64; o <<= 1) v += __shfl_xor(v, o);
    return v;
}
__device__ __forceinline__ float wave_max(float v) {
#pragma unroll
    for (int o = 1; o < 64; o <<= 1) v = fmaxf(v, __shfl_xor(v, o));
    return v;
}
__device__ __forceinline__ float dot8(v4u a, v4u b, float s) {
    s += bflo(a.x) * bflo(b.x); s += bfhi(a.x) * bfhi(b.x); s += bflo(a.y) * bflo(b.y); s += bfhi(a.y) * bfhi(b.y);
    s += bflo(a.z) * bflo(b.z); s += bfhi(a.z) * bfhi(b.z); s += bflo(a.w) * bflo(b.w); s += bfhi(a.w) * bfhi(b.w);
    return s;
}
__device__ __forceinline__ float silu_f(float x) { return x / (1.f + __expf(-x)); }
__device__ __forceinline__ float sigmoid_f(float x) { return 1.f / (1.f + __expf(-x)); }
__device__ __forceinline__ int t5_bucket(int d) {
    if (d < 16) return d;
    int v = 16 + (int)(logf((float)d * (1.f / 16.f)) / 4.852030263919617f * 16.f);
    return v < 31 ? v : 31;
}
__host__ __device__ __forceinline__ float lam_init_of(int layer) { return layer == 0 ? 0.2f : 0.35550906759f; }

struct EpiResid {
    static constexpr bool PERM = false, AFTER_DRAIN = false;
    const float* res; float* out; int ldc; float alpha;
    __device__ __forceinline__ void operator()(const pg8::f32x4 (&acc)[2][2][4][2], const pg8::Unit& u, int wr, int wc, int fr, int fq) const {
        const int row0 = u.pm * pg8::BM + wr * 64 + fr, col0 = u.pn * pg8::BM + wc * 32 + 4 * fq;
#pragma unroll
        for (int ai = 0; ai < 2; ++ai)
#pragma unroll
            for (int m = 0; m < 4; ++m) { const size_t off = (size_t)(row0 + ai * pg8::HALF + m * 16) * ldc + col0;
                pg8::f32x4 r[2][2];
#pragma unroll
                for (int bj = 0; bj < 2; ++bj)
#pragma unroll
                    for (int n = 0; n < 2; ++n) r[bj][n] = *(const pg8::f32x4*)(res + off + bj * pg8::HALF + n * 16);
#pragma unroll
                for (int bj = 0; bj < 2; ++bj)
#pragma unroll
                    for (int n = 0; n < 2; ++n) *(pg8::f32x4*)(out + off + bj * pg8::HALF + n * 16) = r[bj][n] * alpha + acc[ai][bj][m][n];
                asm volatile("" ::: "memory"); }
    }
};

struct Frame {
    LAS unsigned char* lds;
    int G;
    const float *x, *w_in, *diff_lambda, *head_gain, *conv_dw, *conv_b, *conv_ln_g, *conv_ln_b, *conv_pw, *w_out, *ln_g, *ln_b, *rel_bias;
    float* out;
    bf16 *win_t, *wout_t, *wpw_t, *xb, *ymix, *proj;
    float *biasA, *biasB, *lamv;
    unsigned* ctl;
};

#define PHASE_IDS() int tid_ = threadIdx.x; asm volatile("" : "+v"(tid_)); const int tid = tid_, lane = tid & 63, wave = __builtin_amdgcn_readfirstlane(tid >> 6); (void)tid; (void)lane; (void)wave
__device__ __forceinline__ void p0_transpose_item(const float* W, int K, int N, bf16* WT, LAS float* scr, int item, int lane) {
    const int nblk = N / 32, kb = item / nblk, nb = item % nblk, k0 = 64 * kb, n0 = 32 * nb;
#pragma unroll 8
    for (int i = 0; i < 32; ++i) { const int kk = 2 * i + (lane >> 5); scr[kk * 33 + (lane & 31)] = W[(size_t)(k0 + kk) * N + n0 + (lane & 31)]; }
    LDS_WAIT(); asm volatile("" ::: "memory");
    const int c = lane & 7;
#pragma unroll
    for (int j = 0; j < 4; ++j) { const int n = (lane >> 3) + 8 * j; const LAS float* s = scr + (8 * c) * 33 + n;
        v4u o; o.x = pk2(s[0 * 33], s[1 * 33]); o.y = pk2(s[2 * 33], s[3 * 33]); o.z = pk2(s[4 * 33], s[5 * 33]); o.w = pk2(s[6 * 33], s[7 * 33]);
        *(GAS v4u*)(WT + (size_t)(n0 + n) * K + k0 + 8 * c) = o; }
    LDS_WAIT(); asm volatile("" ::: "memory");
}

__device__ __forceinline__ void p0_prologue(Frame& F) {
    PHASE_IDS();
    LAS float* scr = (LAS float*)(F.lds + wave * 16384);
    const int gw = blockIdx.x * NWAVES + wave, NGW = F.G * NWAVES;
    constexpr int I_IN = (DM / 64) * (DIN / 32), I_OUT = (DM / 64) * (DM / 32), I_PW = (DC / 64) * (DC / 32);
    constexpr int NITEMS = DEPTH * (I_IN + I_OUT + I_PW);
    for (int it = gw; it < NITEMS; it += NGW) {
        int r = it;
        if (r < DEPTH * I_IN) { const int l = r / I_IN; r -= l * I_IN; p0_transpose_item(F.w_in + (size_t)l * DM * DIN, DM, DIN, F.win_t + (size_t)l * DIN * DM, scr, r, lane); continue; }
        r -= DEPTH * I_IN;
        if (r < DEPTH * I_OUT) { const int l = r / I_OUT; r -= l * I_OUT; p0_transpose_item(F.w_out + (size_t)l * DM * DM, DM, DM, F.wout_t + (size_t)l * DM * DM, scr, r, lane); continue; }
        r -= DEPTH * I_OUT;
        { const int l = r / I_PW; r -= l * I_PW; p0_transpose_item(F.conv_pw + (size_t)l * DC * DC, DC, DC, F.wpw_t + (size_t)l * DC * DC, scr, r, lane); }
    }
    { const size_t n8 = (size_t)MROWS * DM / 8;
      for (size_t i = (size_t)gw * 64 + lane; i < n8; i += (size_t)NGW * 64) {
          const f32x4 a = *(const GAS f32x4*)(F.x + i * 8), b = *(const GAS f32x4*)(F.x + i * 8 + 4);
          v4u o; o.x = pk2(a.x, a.y); o.y = pk2(a.z, a.w); o.z = pk2(b.x, b.y); o.w = pk2(b.z, b.w);
          *(GAS v4u*)(F.xb + i * 8) = o; } }
    { const int gt = blockIdx.x * (NWAVES * 64) + tid, NT = F.G * NWAVES * 64;
      for (int i = gt; i < 4 * 2048; i += NT) { const int h = i >> 11, d = i & 2047; F.biasA[i] = F.rel_bias[t5_bucket(d) * 12 + h]; }
      for (int i = gt; i < 3 * 8 * 132; i += NT) { const int p = i / (8 * 132), h = (i / 132) % 8, j = i % 132; const int dil = p == 0 ? 1 : (p == 1 ? 4 : 16);
          F.biasB[i] = (j <= 128) ? F.rel_bias[t5_bucket(j * dil) * 12 + 4 + h] : 0.f; }
      if (gt < DEPTH) { const float* lv = F.diff_lambda + gt * 4 * 64; float s0 = 0.f, s1 = 0.f;
          for (int i = 0; i < 64; ++i) { s0 += lv[i] * lv[64 + i]; s1 += lv[128 + i] * lv[192 + i]; }
          F.lamv[gt] = expf(s0) - expf(s1) + lam_init_of(gt); } }
}

__device__ __forceinline__ void naive_mixer_a(Frame& F, int layer) {
    PHASE_IDS();
    LAS float* sc = (LAS float*)(F.lds) + wave * 4096;
    const float lam = F.lamv[layer], li = lam_init_of(layer);
    const int gw = blockIdx.x * NWAVES + wave, NGW = F.G * NWAVES;
    for (int item = gw; item < MROWS * 4; item += NGW) {
        const int h = item & 3, bt = item >> 2, t = bt & (SEQ - 1), b = bt >> 11;
        const bf16* base = F.proj + (size_t)(b * SEQ) * DIN;
        const bf16* qp = base + (size_t)t * DIN + C_AQ + h * 128;
        v4u q[16];
#pragma unroll
        for (int i = 0; i < 16; ++i) q[i] = *(const GAS v4u*)(qp + i * 8);
        float m0 = -INFINITY, m1 = -INFINITY;
        for (int k = lane; k <= t; k += 64) {
            const bf16* kp = base + (size_t)k * DIN + C_AK + h * 128;
            float s0 = 0.f, s1 = 0.f;
#pragma unroll
            for (int i = 0; i < 8; ++i) s0 = dot8(q[i], *(const GAS v4u*)(kp + i * 8), s0);
#pragma unroll
            for (int i = 8; i < 16; ++i) s1 = dot8(q[i], *(const GAS v4u*)(kp + i * 8), s1);
            const float bias = F.biasA[h * 2048 + (t - k)];
            s0 = s0 * 0.125f + bias; s1 = s1 * 0.125f + bias;
            sc[k] = s0; sc[2048 + k] = s1; m0 = fmaxf(m0, s0); m1 = fmaxf(m1, s1);
        }
        m0 = wave_max(m0); m1 = wave_max(m1);
        float l0 = 0.f, l1 = 0.f;
        for (int k = lane; k <= t; k += 64) { const float p0 = __expf(sc[k] - m0), p1 = __expf(sc[2048 + k] - m1); sc[k] = p0; sc[2048 + k] = p1; l0 += p0; l1 += p1; }
        l0 = wave_sum(l0); l1 = wave_sum(l1);
        const float i0 = 1.f / l0, i1 = lam / l1;
        for (int k = lane; k <= t; k += 64) sc[k] = sc[k] * i0 - sc[2048 + k] * i1;
        LDS_WAIT(); asm volatile("" ::: "memory");
        float a0 = 0.f, a1 = 0.f;
        const bf16* vp = base + C_AV + h * 128 + 2 * lane;
        for (int k = 0; k <= t; ++k) { const float a = sc[k]; const unsigned v = *(const GAS unsigned*)(vp + (size_t)k * DIN); a0 += a * bflo(v); a1 += a * bfhi(v); }
        const float ss = wave_sum(a0 * a0 + a1 * a1);
        const float r = rsqrtf(ss * (1.f / 128.f) + LN_EPS) * (1.f - li);
        const float g0 = F.head_gain[layer * 128 + 2 * lane], g1 = F.head_gain[layer * 128 + 2 * lane + 1];
        const unsigned ag = *(const GAS unsigned*)(base + (size_t)t * DIN + C_AG + h * 128 + 2 * lane);
        const float o0 = a0 * r * g0 * silu_f(bflo(ag)), o1 = a1 * r * g1 * silu_f(bfhi(ag));
        *(GAS unsigned*)(F.ymix + (size_t)(b * SEQ + t) * DM + Y_A + h * 128 + 2 * lane) = pk2(o0, o1);
        LDS_WAIT(); asm volatile("" ::: "memory");
    }
}

__device__ __forceinline__ void naive_mixer_b(Frame& F, int layer) {
    PHASE_IDS();
    LAS float* sc = (LAS float*)(F.lds) + wave * 512;
    const int gw = blockIdx.x * NWAVES + wave, NGW = F.G * NWAVES;
    const float scale = 0.08838834764831845f;
    for (int item = gw; item < MROWS * 8; item += NGW) {
        const int h = item & 7, bt = item >> 3, t = bt & (SEQ - 1), b = bt >> 11;
        const bf16* base = F.proj + (size_t)(b * SEQ) * DIN;
        const bf16* qp = base + (size_t)t * DIN + C_BQ + h * 128;
        v4u q[16];
#pragma unroll
        for (int i = 0; i < 16; ++i) q[i] = *(const GAS v4u*)(qp + i * 8);
        float m = -INFINITY;
#pragma unroll
        for (int p = 0; p < 3; ++p) { const int dil = p == 0 ? 1 : (p == 1 ? 4 : 16);
            for (int j = lane; j <= 128; j += 64) { const int tk = t - j * dil; float s = -INFINITY;
                if (tk >= 0) { const bf16* kp = base + (size_t)tk * DIN + C_BK + h * 128; s = 0.f;
#pragma unroll
                    for (int i = 0; i < 16; ++i) s = dot8(q[i], *(const GAS v4u*)(kp + i * 8), s);
                    s = s * scale + F.biasB[(p * 8 + h) * 132 + j]; }
                sc[p * 132 + j] = s; m = fmaxf(m, s); } }
        m = wave_max(m);
        float l = 0.f;
#pragma unroll
        for (int p = 0; p < 3; ++p) for (int j = lane; j <= 128; j += 64) { const float e = __expf(sc[p * 132 + j] - m); sc[p * 132 + j] = e; l += e; }
        l = wave_sum(l);
        LDS_WAIT(); asm volatile("" ::: "memory");
        float a0 = 0.f, a1 = 0.f;
        const bf16* vp = base + C_BV + h * 128 + 2 * lane;
#pragma unroll
        for (int p = 0; p < 3; ++p) { const int dil = p == 0 ? 1 : (p == 1 ? 4 : 16); int jmax = t / dil; jmax = jmax < 128 ? jmax : 128;
            for (int j = 0; j <= jmax; ++j) { const float a = sc[p * 132 + j]; const unsigned v = *(const GAS unsigned*)(vp + (size_t)(t - j * dil) * DIN); a0 += a * bflo(v); a1 += a * bfhi(v); } }
        const float il = 1.f / l;
        const unsigned bg = *(const GAS unsigned*)(base + (size_t)t * DIN + C_BG + h * 128 + 2 * lane);
        *(GAS unsigned*)(F.ymix + (size_t)(b * SEQ + t) * DM + Y_B + h * 128 + 2 * lane) = pk2(a0 * il * silu_f(bflo(bg)), a1 * il * silu_f(bfhi(bg)));
        LDS_WAIT(); asm volatile("" ::: "memory");
    }
}

__device__ __forceinline__ void naive_mixer_c(Frame& F, int layer) {
    PHASE_IDS();
    LAS float* hb = (LAS float*)(F.lds) + wave * 512;
    const int gw = blockIdx.x * NWAVES + wave, NGW = F.G * NWAVES, c0 = lane * 8;
    const float* dw = F.conv_dw + (size_t)layer * CONVW * DC; const float* pw = F.conv_pw + (size_t)layer * DC * DC;
    for (int item = gw; item < MROWS; item += NGW) {
        const int t = item & (SEQ - 1), b = item >> 11;
        const bf16* base = F.proj + (size_t)(b * SEQ) * DIN;
        float acc[8];
#pragma unroll
        for (int i = 0; i < 8; ++i) acc[i] = F.conv_b[layer * DC + c0 + i];
        for (int j = 0; j < CONVW; ++j) { const int tk = t - (CONVW - 1) + j; if (tk < 0) continue;
            const v4u u = *(const GAS v4u*)(base + (size_t)tk * DIN + C_CU + c0), g = *(const GAS v4u*)(base + (size_t)tk * DIN + C_CGLU + c0);
            const f32x4 w0 = *(const GAS f32x4*)(dw + j * DC + c0), w1 = *(const GAS f32x4*)(dw + j * DC + c0 + 4);
            acc[0] += w0.x * (bflo(u.x) * sigmoid_f(bflo(g.x))); acc[1] += w0.y * (bfhi(u.x) * sigmoid_f(bfhi(g.x)));
            acc[2] += w0.z * (bflo(u.y) * sigmoid_f(bflo(g.y))); acc[3] += w0.w * (bfhi(u.y) * sigmoid_f(bfhi(g.y)));
            acc[4] += w1.x * (bflo(u.z) * sigmoid_f(bflo(g.z))); acc[5] += w1.y * (bfhi(u.z) * sigmoid_f(bfhi(g.z)));
            acc[6] += w1.z * (bflo(u.w) * sigmoid_f(bflo(g.w))); acc[7] += w1.w * (bfhi(u.w) * sigmoid_f(bfhi(g.w))); }
        float s = 0.f;
#pragma unroll
        for (int i = 0; i < 8; ++i) s += acc[i];
        const float mean = wave_sum(s) * (1.f / DC); float s2 = 0.f;
#pragma unroll
        for (int i = 0; i < 8; ++i) { acc[i] -= mean; s2 += acc[i] * acc[i]; }
        const float rstd = rsqrtf(wave_sum(s2) * (1.f / DC) + LN_EPS);
#pragma unroll
        for (int i = 0; i < 8; ++i) { const float hn = acc[i] * rstd * F.conv_ln_g[layer * DC + c0 + i] + F.conv_ln_b[layer * DC + c0 + i]; hb[c0 + i] = silu_f(hn); }
        LDS_WAIT(); asm volatile("" ::: "memory");
        float o[8];
#pragma unroll
        for (int i = 0; i < 8; ++i) o[i] = 0.f;
        for (int c = 0; c < DC; ++c) { const float hv = hb[c]; const f32x4 w0 = *(const GAS f32x4*)(pw + (size_t)c * DC + c0), w1 = *(const GAS f32x4*)(pw + (size_t)c * DC + c0 + 4);
            o[0] += hv * w0.x; o[1] += hv * w0.y; o[2] += hv * w0.z; o[3] += hv * w0.w; o[4] += hv * w1.x; o[5] += hv * w1.y; o[6] += hv * w1.z; o[7] += hv * w1.w; }
        const v4u cg = *(const GAS v4u*)(base + (size_t)t * DIN + C_CG + c0);
        v4u ov; ov.x = pk2(o[0] * silu_f(bflo(cg.x)), o[1] * silu_f(bfhi(cg.x))); ov.y = pk2(o[2] * silu_f(bflo(cg.y)), o[3] * silu_f(bfhi(cg.y)));
        ov.z = pk2(o[4] * silu_f(bflo(cg.z)), o[5] * silu_f(bfhi(cg.z))); ov.w = pk2(o[6] * silu_f(bflo(cg.w)), o[7] * silu_f(bfhi(cg.w)));
        *(GAS v4u*)(F.ymix + (size_t)(b * SEQ + t) * DM + Y_C + c0) = ov;
        LDS_WAIT(); asm volatile("" ::: "memory");
    }
}

__device__ __forceinline__ void ln_phase(Frame& F, int layer, bool write_xb) {
    PHASE_IDS();
    const int gw = blockIdx.x * NWAVES + wave, NGW = F.G * NWAVES;
    const float* g = F.ln_g + layer * DM; const float* bb = F.ln_b + layer * DM;
    for (int row = gw; row < MROWS; row += NGW) {
        GAS f32x4* xr = (GAS f32x4*)(F.out + (size_t)row * DM) + lane;
        f32x4 v[8]; float s = 0.f;
#pragma unroll
        for (int j = 0; j < 8; ++j) { v[j] = xr[64 * j]; s += (v[j].x + v[j].y) + (v[j].z + v[j].w); }
        const float mean = wave_sum(s) * (1.f / DM); float s2 = 0.f;
#pragma unroll
        for (int j = 0; j < 8; ++j) { v[j] = v[j] - mean; s2 += (v[j].x * v[j].x + v[j].y * v[j].y) + (v[j].z * v[j].z + v[j].w * v[j].w); }
        const float rstd = rsqrtf(wave_sum(s2) * (1.f / DM) + LN_EPS);
#pragma unroll
        for (int j = 0; j < 8; ++j) { const int c = 4 * lane + 256 * j; const f32x4 gv = *(const GAS f32x4*)(g + c), bv = *(const GAS f32x4*)(bb + c);
            const f32x4 o = v[j] * rstd * gv + bv; xr[64 * j] = o;
            if (write_xb) { v2u w; w.x = pk2(o.x, o.y); w.y = pk2(o.z, o.w); *(GAS v2u*)(F.xb + (size_t)row * DM + c) = w; } }
    }
}


typedef short bf16x8 __attribute__((ext_vector_type(8)));
typedef float f32x16 __attribute__((ext_vector_type(16)));
typedef short s16x4 __attribute__((ext_vector_type(4)));
#define MFMA32(a, b, c) __builtin_amdgcn_mfma_f32_32x32x16_bf16((a), (b), (c), 0, 0, 0)
constexpr int AT_STG = 10240;
constexpr int AT_QIMG = 8448;
constexpr int AT_PAD = 32;
constexpr float AT_MASK = -3.0e38f, AT_MINIT = -1.0e30f;
constexpr float LOG2E = 1.4426950408889634f;

__device__ __forceinline__ s16x4 ds_tr16(LAS const unsigned char* p) {
    typedef short v4i16_t __attribute__((ext_vector_type(4)));
    return __builtin_bit_cast(s16x4, __builtin_amdgcn_ds_read_tr16_b64_v4i16((LAS v4i16_t*)p));
}
__device__ __forceinline__ unsigned cvtpk(float lo, float hi) { typedef float f2 __attribute__((ext_vector_type(2))); typedef __bf16 b2 __attribute__((ext_vector_type(2))); f2 v = {lo, hi}; b2 b = __builtin_convertvector(v, b2); return __builtin_bit_cast(unsigned, b); }

struct RowMap { int p0, str, hi; };
__device__ __forceinline__ void tile_load(v4u (&st)[8], const bf16* base, int col, const RowMap rm, int lane) {
    const bf16* gp = base + (size_t)(rm.p0 + (lane >> 4) * rm.str) * DIN + col + (lane & 15) * 8;
#pragma unroll
    for (int i = 0; i < 8; ++i) st[i] = *(const GAS v4u*)(gp + (size_t)(4 * (i & 3) * rm.str + (i >> 2) * rm.hi) * DIN);
}
__device__ __forceinline__ void kimg_store(LAS unsigned char* img, const v4u (&st)[8], int lane) {
    LAS unsigned char* p = img + (lane & 15) * 528 + (lane >> 4) * 16;
#pragma unroll
    for (int i = 0; i < 8; ++i) *(LAS v4u*)(p + i * 64) = st[i];
}
__device__ __forceinline__ bf16x8 kimg_frag(LAS const unsigned char* img, int c, int lane) {
    return *(LAS const bf16x8*)(img + (lane >> 5) * 528 + (lane & 31) * 16 + c * 1056);
}
__device__ __forceinline__ void vimg_store(LAS unsigned char* img, const v4u (&st)[8], int lane) {
    LAS unsigned char* p = img + (lane >> 4) * 320 + (lane & 15) * 16;
#pragma unroll
    for (int i = 0; i < 8; ++i) *(LAS v4u*)(p + i * 1280) = st[i];
}

template <int NS> struct AttnState { f32x16 o[NS][4]; float m[NS], l[NS]; };

template <int NS>
__device__ __forceinline__ void attn_subtile(AttnState<NS>& S, const bf16x8* qf, LAS const unsigned char* qimg, LAS unsigned char* stg, const bf16* base, int colK, int colV, const RowMap krm,
                                             LAS const float* tab, int jlo, int jhi, float c1, int lane) {
    v4u kst[8], vst[8];
    tile_load(kst, base, colK, krm, lane);
    tile_load(vst, base, colV, krm, lane);
    kimg_store(stg, kst, lane);
    asm volatile("" ::: "memory");
    f32x16 p[NS];
#pragma unroll
    for (int s = 0; s < NS; ++s) {
        f32x16 acc = {0.f, 0.f, 0.f, 0.f, 0.f, 0.f, 0.f, 0.f, 0.f, 0.f, 0.f, 0.f, 0.f, 0.f, 0.f, 0.f};
        constexpr int NC = 8 / NS;
#pragma unroll
        for (int c = 0; c < NC; ++c) { const bf16x8 kf = kimg_frag(stg, s * NC + c, lane); const bf16x8 q = (NS == 1) ? qf[c] : kimg_frag(qimg, s * NC + c, lane); acc = MFMA32(kf, q, acc); }
        p[s] = acc;
    }
    asm volatile("" ::: "memory");
    vimg_store(stg, vst, lane);
    asm volatile("" ::: "memory");
    float bias[16];
    { LAS const float* tl = tab + jlo; LAS const float* th = tab + jhi;
#pragma unroll
      for (int r = 0; r < 8; ++r) bias[r] = tl[(r & 3) + 8 * (r >> 2)];
#pragma unroll
      for (int r = 8; r < 16; ++r) bias[r] = th[(r & 3) + 8 * (r >> 2)]; }
    unsigned pb[NS][2][4];
#pragma unroll
    for (int s = 0; s < NS; ++s) {
        float mx = AT_MASK;
#pragma unroll
        for (int r = 0; r < 16; ++r) { p[s][r] = p[s][r] * c1 + bias[r]; mx = fmaxf(mx, p[s][r]); }
        mx = fmaxf(mx, __shfl_xor(mx, 32));
        const float mn = fmaxf(S.m[s], mx);
        if (__any(mn > S.m[s])) {
            const float al = __builtin_amdgcn_exp2f(S.m[s] - mn);
            S.l[s] *= al;
#pragma unroll
            for (int d = 0; d < 4; ++d)
#pragma unroll
                for (int r = 0; r < 16; ++r) S.o[s][d][r] *= al;
            S.m[s] = mn;
        }
        float ls = 0.f;
#pragma unroll
        for (int r = 0; r < 16; ++r) { p[s][r] = __builtin_amdgcn_exp2f(p[s][r] - mn); ls += p[s][r]; }
        S.l[s] += ls;
#pragma unroll
        for (int k = 0; k < 2; ++k)
#pragma unroll
            for (int j = 0; j < 4; ++j) pb[s][k][j] = cvtpk(p[s][8 * k + 2 * j], p[s][8 * k + 2 * j + 1]);
    }
    LAS const unsigned char* vb = stg + (4 * (lane >> 5) + ((lane & 15) >> 2)) * 320 + (16 * ((lane >> 4) & 1) + 4 * (lane & 3)) * 2;
#pragma unroll
    for (int d = 0; d < 4; ++d)
#pragma unroll
        for (int k = 0; k < 2; ++k) {
            const s16x4 lo = ds_tr16(vb + d * 64 + (16 * k) * 320), hi = ds_tr16(vb + d * 64 + (16 * k + 8) * 320);
            const bf16x8 vf = {lo[0], lo[1], lo[2], lo[3], hi[0], hi[1], hi[2], hi[3]};
#pragma unroll
            for (int s = 0; s < NS; ++s) { const v4u w = {pb[s][k][0], pb[s][k][1], pb[s][k][2], pb[s][k][3]}; S.o[s][d] = MFMA32(vf, __builtin_bit_cast(bf16x8, w), S.o[s][d]); }
        }
    asm volatile("" ::: "memory");
}
template <int NS> __device__ __forceinline__ void attn_init(AttnState<NS>& S) {
#pragma unroll
    for (int s = 0; s < NS; ++s) { S.m[s] = AT_MINIT; S.l[s] = 0.f;
#pragma unroll
        for (int d = 0; d < 4; ++d) S.o[s][d] = (f32x16){0.f, 0.f, 0.f, 0.f, 0.f, 0.f, 0.f, 0.f, 0.f, 0.f, 0.f, 0.f, 0.f, 0.f, 0.f, 0.f}; }
}

constexpr int MX_STG = 0;
constexpr int MX_QIMG = 8 * AT_STG;
constexpr int MX_TABA = MX_QIMG + 8 * AT_QIMG;
constexpr int TABA_N = 2048 + 2 * AT_PAD + 1;
constexpr int MX_ITEM = 163840 - 64;
static_assert(MX_TABA + TABA_N * 4 <= MX_ITEM, "mixer A LDS map");

__device__ __forceinline__ void mixer_a_block(Frame& F, int layer, int b, int h, int qb, int wave, int lane) {
    LAS unsigned char* stg = F.lds + MX_STG + wave * AT_STG;
    LAS unsigned char* qimg = F.lds + MX_QIMG + wave * AT_QIMG;
    LAS const float* tab = (LAS const float*)(F.lds + MX_TABA);
    const bf16* base = F.proj + (size_t)(b * SEQ) * DIN;
    const int q0 = qb * 256 + wave * 32;
    { v4u st[8]; tile_load(st, base, C_AQ + h * 128, RowMap{q0, 1, 16}, lane); kimg_store(qimg, st, lane); }
    asm volatile("" ::: "memory");
    AttnState<2> S; attn_init<2>(S);
    const int nsub = q0 / 32 + 1;
    const int hi = lane >> 5, ql = lane & 31;
    int jb = AT_PAD + 2047 - q0 - ql + 4 * hi;
#pragma unroll 1
    for (int u = 0; u < nsub; ++u, jb += 32)
        attn_subtile<2>(S, nullptr, qimg, stg, base, C_AK + h * 128, C_AV + h * 128, RowMap{32 * u, 1, 16}, tab, jb, jb, 0.125f * LOG2E, lane);
    const float lam = F.lamv[layer], li = lam_init_of(layer);
    const float l0 = S.l[0] + __shfl_xor(S.l[0], 32), l1 = S.l[1] + __shfl_xor(S.l[1], 32);
    const float i0 = 1.f / l0, i1 = lam / l1;
    float ss = 0.f;
#pragma unroll
    for (int d = 0; d < 4; ++d)
#pragma unroll
        for (int r = 0; r < 16; ++r) { const float v = S.o[0][d][r] * i0 - S.o[1][d][r] * i1; S.o[0][d][r] = v; ss += v * v; }
    ss += __shfl_xor(ss, 32);
    const float rn = rsqrtf(ss * (1.f / 128.f) + LN_EPS) * (1.f - li);
    const size_t row = (size_t)(b * SEQ + q0 + ql);
    const bf16* gp = F.proj + row * DIN + C_AG + h * 128 + 4 * hi;
    bf16* op = F.ymix + row * DM + Y_A + h * 128 + 4 * hi;
    const float* gn = F.head_gain + layer * 128 + 4 * hi;
#pragma unroll
    for (int d = 0; d < 4; ++d)
#pragma unroll
        for (int g = 0; g < 4; ++g) {
            const int dd = 32 * d + 8 * g;
            const v2u ag = *(const GAS v2u*)(gp + dd); const f32x4 gv = *(const GAS f32x4*)(gn + dd);
            v2u o; o.x = pk2(S.o[0][d][4 * g] * rn * gv.x * silu_f(bflo(ag.x)), S.o[0][d][4 * g + 1] * rn * gv.y * silu_f(bfhi(ag.x)));
            o.y = pk2(S.o[0][d][4 * g + 2] * rn * gv.z * silu_f(bflo(ag.y)), S.o[0][d][4 * g + 3] * rn * gv.w * silu_f(bfhi(ag.y)));
            *(GAS v2u*)(op + dd) = o;
        }
}
__device__ __forceinline__ void mixer_a_item(Frame& F, int layer, int item, int tid_, int wave_, int lane_) {
    int tid = tid_, wave = wave_, lane = lane_; asm volatile("" : "+v"(tid), "+s"(wave), "+v"(lane));
    const int pr = item & 3, bh = item >> 2, h = bh & 3, b = bh >> 2;
    LAS float* tab = (LAS float*)(F.lds + MX_TABA);
    for (int j = tid; j < TABA_N; j += NWAVES * 64) { const int rel = 2047 + AT_PAD - j; tab[j] = (rel >= 0 && rel <= 2047) ? F.biasA[h * 2048 + rel] * LOG2E : AT_MASK; }
    __syncthreads();
    mixer_a_block(F, layer, b, h, 7 - pr, wave, lane);
    mixer_a_block(F, layer, b, h, pr, wave, lane);
    __syncthreads();
}

constexpr int MX_STO = 8 * AT_STG;
constexpr int MX_STM = MX_STO + 256 * 264, MX_STL = MX_STM + 1024;
constexpr int MX_TABB = MX_STL + 1024, TABB_N = 200;
static_assert(MX_TABB + 3 * TABB_N * 4 <= MX_ITEM, "mixer B LDS map");
__device__ __forceinline__ int st_row(int t) { return (t & 0xE0) | ((t & 31) ^ ((t >> 5) & 7) ^ (((t >> 5) & 1) << 3)); }

__device__ __forceinline__ void b_state_save(Frame& F, const AttnState<1>& S, int tau, int lane) {
    const int hi = lane >> 5;
    LAS unsigned char* row = F.lds + MX_STO + st_row(tau) * 264 + hi * 8;
#pragma unroll
    for (int d = 0; d < 4; ++d)
#pragma unroll
        for (int g = 0; g < 4; ++g) { v2u w; w.x = cvtpk(S.o[0][d][4 * g], S.o[0][d][4 * g + 1]); w.y = cvtpk(S.o[0][d][4 * g + 2], S.o[0][d][4 * g + 3]);
            *(LAS v2u*)(row + (8 * d + 2 * g) * 8) = w; }
    const float lt = S.l[0] + __shfl_xor(S.l[0], 32);
    if (hi == 0) { ((LAS float*)(F.lds + MX_STM))[tau] = S.m[0]; ((LAS float*)(F.lds + MX_STL))[tau] = lt; }
}
__device__ __forceinline__ void b_state_load(Frame& F, AttnState<1>& S, int tau, int lane) {
    const int hi = lane >> 5;
    LAS const unsigned char* row = F.lds + MX_STO + st_row(tau) * 264 + hi * 8;
#pragma unroll
    for (int d = 0; d < 4; ++d)
#pragma unroll
        for (int g = 0; g < 4; ++g) { const v2u w = *(LAS const v2u*)(row + (8 * d + 2 * g) * 8);
            S.o[0][d][4 * g] = bflo(w.x); S.o[0][d][4 * g + 1] = bfhi(w.x); S.o[0][d][4 * g + 2] = bflo(w.y); S.o[0][d][4 * g + 3] = bfhi(w.y); }
    S.m[0] = ((LAS const float*)(F.lds + MX_STM))[tau];
    const float lt = ((LAS const float*)(F.lds + MX_STL))[tau];
    S.l[0] = hi == 0 ? lt : 0.f;
}
__device__ __forceinline__ void b_load_q(bf16x8 (&qf)[8], LAS unsigned char* stg, const bf16* base, int col, const RowMap rm, int lane) {
    v4u st[8]; tile_load(st, base, col, rm, lane); kimg_store(stg, st, lane);
    asm volatile("" ::: "memory");
#pragma unroll
    for (int c = 0; c < 8; ++c) qf[c] = kimg_frag(stg, c, lane);
    asm volatile("" ::: "memory");
}

__device__ __forceinline__ void mixer_b_item(Frame& F, int layer, int item, int tid_, int wave_, int lane_) {
    int tid = tid_, wave = wave_, lane = lane_; asm volatile("" : "+v"(tid), "+s"(wave), "+v"(lane));
    const int blk = item & 7, bh = item >> 3, h = bh & 7, b = bh >> 3, T0 = blk * 256;
    LAS float* tabs = (LAS float*)(F.lds + MX_TABB);
    for (int j = tid; j < 3 * TABB_N; j += NWAVES * 64) { const int p = j / TABB_N, jj = j - p * TABB_N, rel = 128 + AT_PAD - jj;
        tabs[j] = (rel >= 0 && rel <= 128) ? F.biasB[(p * 8 + h) * 132 + rel] * LOG2E : AT_MASK; }
    __syncthreads();
    LAS unsigned char* stg = F.lds + MX_STG + wave * AT_STG;
    const bf16* base = F.proj + (size_t)(b * SEQ) * DIN;
    const int colQ = C_BQ + h * 128, colK = C_BK + h * 128, colV = C_BV + h * 128;
    const float c1 = 0.08838834764831845f * LOG2E;
    const int hi = lane >> 5, ql = lane & 31;
    AttnState<1> S; bf16x8 qf[8];
    { attn_init<1>(S);
      b_load_q(qf, stg, base, colQ, RowMap{T0 + 32 * wave, 1, 16}, lane);
      const int k0 = T0 + 32 * wave - 128;
#pragma unroll 1
      for (int u = 0; u < 5; ++u) { if (k0 + 32 * u < 0) continue; const int jb = AT_PAD - ql + 32 * u + 4 * hi;
          attn_subtile<1>(S, qf, nullptr, stg, base, colK, colV, RowMap{k0 + 32 * u, 1, 16}, tabs, jb, jb, c1, lane); }
      b_state_save(F, S, 32 * wave + ql, lane); }
    __syncthreads();
    { const int r = wave & 3, c = wave >> 2, tau = 128 * c + 4 * ql + r;
      b_state_load(F, S, tau, lane);
      b_load_q(qf, stg, base, colQ, RowMap{T0 + 128 * c + r, 4, 64}, lane);
      const int l0 = T0 / 4 + 32 * c - 128;
#pragma unroll 1
      for (int u = 0; u < 5; ++u) { if (l0 + 32 * u < 0) continue; const int jb = AT_PAD - ql + 32 * u + 4 * hi;
          attn_subtile<1>(S, qf, nullptr, stg, base, colK, colV, RowMap{4 * (l0 + 32 * u) + r, 4, 64}, tabs + TABB_N, jb, jb, c1, lane); }
      b_state_save(F, S, tau, lane); }
    __syncthreads();
    { const int tau = 16 * (ql & 15) + 2 * wave + (ql >> 4);
      b_state_load(F, S, tau, lane);
      b_load_q(qf, stg, base, colQ, RowMap{T0 + 2 * wave, 16, 1}, lane);
      const int L0 = T0 / 16, x0 = L0 - 128;
#pragma unroll 1
      for (int v = 0; v < 9; ++v) { if (x0 + 16 * v < 0) continue; const int jv = AT_PAD + 16 * v - ql + 4 * hi;
          attn_subtile<1>(S, qf, nullptr, stg, base, colK, colV, RowMap{16 * (x0 + 16 * v) + 2 * wave, 16, 1}, tabs + 2 * TABB_N, (ql < 16) ? jv : 0, (ql < 16) ? 0 : jv, c1, lane); }
      const float lt = S.l[0] + __shfl_xor(S.l[0], 32), il = 1.f / lt;
      const size_t row = (size_t)(b * SEQ + T0 + tau);
      const bf16* gp = F.proj + row * DIN + C_BG + h * 128 + 4 * hi;
      bf16* op = F.ymix + row * DM + Y_B + h * 128 + 4 * hi;
#pragma unroll
      for (int d = 0; d < 4; ++d)
#pragma unroll
          for (int g = 0; g < 4; ++g) { const int dd = 32 * d + 8 * g; const v2u bg = *(const GAS v2u*)(gp + dd);
              v2u o; o.x = pk2(S.o[0][d][4 * g] * il * silu_f(bflo(bg.x)), S.o[0][d][4 * g + 1] * il * silu_f(bfhi(bg.x)));
              o.y = pk2(S.o[0][d][4 * g + 2] * il * silu_f(bflo(bg.y)), S.o[0][d][4 * g + 3] * il * silu_f(bfhi(bg.y)));
              *(GAS v2u*)(op + dd) = o; } }
    __syncthreads();
}

constexpr int MC_AIMG = 0, MC_ACH = 64 * 16 + 16;
constexpr int MC_PART = 64 * MC_ACH;
constexpr int MC_STAT = MC_PART + 2 * 64 * 64 * 4;
static_assert(MC_STAT + 512 <= MX_ITEM, "mixer C LDS map");
typedef float f32x2 __attribute__((ext_vector_type(2)));

template <int I0> __device__ __forceinline__ void conv_group(f32x2 (&acc)[32], const f32x2 (&w)[CONVW], const bf16* base, int tb, int c0) {
    f32x2 g[8];
#pragma unroll
    for (int ii = 0; ii < 8; ++ii) { const int i = I0 + ii; if (i < 32 + CONVW - 1) {
        const int tk = tb + i, tc = tk < 0 ? 0 : tk;
        const unsigned u = *(const GAS unsigned*)(base + (size_t)tc * DIN + C_CU + c0), gl = *(const GAS unsigned*)(base + (size_t)tc * DIN + C_CGLU + c0);
        g[ii].x = bflo(u) * sigmoid_f(bflo(gl)); g[ii].y = bfhi(u) * sigmoid_f(bfhi(gl));
        if (tk < 0) { g[ii].x = 0.f; g[ii].y = 0.f; } } }
#pragma unroll
    for (int ii = 0; ii < 8; ++ii)
#pragma unroll
        for (int j = 0; j < CONVW; ++j) { const int i = I0 + ii, o = i - j; if (i < 32 + CONVW - 1 && o >= 0 && o < 32) acc[o] = w[j] * g[ii] + acc[o]; }
    asm volatile("" ::: "memory");
}

__device__ __forceinline__ void mixer_c_item(Frame& F, int layer, int item, int tid_, int wave_, int lane_) {
    int tid = tid_, wave = wave_, lane = lane_; asm volatile("" : "+v"(tid), "+s"(wave), "+v"(lane));
    const int b = item >> 5, t0 = (item & 31) * 64;
    const bf16* base = F.proj + (size_t)(b * SEQ) * DIN;
    const int cp = tid & 255, th = tid >> 8, c0 = 2 * cp;
    f32x2 acc[32];
    {
        f32x2 w[CONVW];
        const float* dw = F.conv_dw + (size_t)layer * CONVW * DC + c0;
#pragma unroll
        for (int j = 0; j < CONVW; ++j) w[j] = *(const GAS f32x2*)(dw + j * DC);
        const f32x2 cb = *(const GAS f32x2*)(F.conv_b + layer * DC + c0);
#pragma unroll
        for (int o = 0; o < 32; ++o) acc[o] = cb;
        const int tb = t0 + 32 * th - (CONVW - 1);
        conv_group<0>(acc, w, base, tb, c0); conv_group<8>(acc, w, base, tb, c0); conv_group<16>(acc, w, base, tb, c0); conv_group<24>(acc, w, base, tb, c0);
        conv_group<32>(acc, w, base, tb, c0); conv_group<40>(acc, w, base, tb, c0); conv_group<48>(acc, w, base, tb, c0); conv_group<56>(acc, w, base, tb, c0);
    }
    { LAS float* part = (LAS float*)(F.lds + MC_PART);
#pragma unroll
      for (int o = 0; o < 32; ++o) { float s1 = acc[o].x + acc[o].y, s2 = acc[o].x * acc[o].x + acc[o].y * acc[o].y;
          s1 += __shfl_xor(s1, 1); s2 += __shfl_xor(s2, 1); s1 += __shfl_xor(s1, 2); s2 += __shfl_xor(s2, 2);
          if ((lane & 3) == 0) { part[(32 * th + o) * 64 + (cp >> 2)] = s1; part[4096 + (32 * th + o) * 64 + (cp >> 2)] = s2; } } }
    __syncthreads();
    { LAS const float* part = (LAS const float*)(F.lds + MC_PART); LAS float* stat = (LAS float*)(F.lds + MC_STAT);
      const int tok = tid >> 3, k = tid & 7;
      const f32x4 a0 = *(LAS const f32x4*)(part + tok * 64 + 8 * k), a1 = *(LAS const f32x4*)(part + tok * 64 + 8 * k + 4);
      const f32x4 b0 = *(LAS const f32x4*)(part + 4096 + tok * 64 + 8 * k), b1 = *(LAS const f32x4*)(part + 4096 + tok * 64 + 8 * k + 4);
      float s1 = (a0.x + a0.y) + (a0.z + a0.w) + (a1.x + a1.y) + (a1.z + a1.w), s2 = (b0.x + b0.y) + (b0.z + b0.w) + (b1.x + b1.y) + (b1.z + b1.w);
      s1 += __shfl_xor(s1, 1); s2 += __shfl_xor(s2, 1); s1 += __shfl_xor(s1, 2); s2 += __shfl_xor(s2, 2); s1 += __shfl_xor(s1, 4); s2 += __shfl_xor(s2, 4);
      const float mean = s1 * (1.f / DC), var = fmaxf(s2 * (1.f / DC) - mean * mean, 0.f);
      if (k == 0) { stat[2 * tok] = mean; stat[2 * tok + 1] = rsqrtf(var + LN_EPS); } }
    __syncthreads();
    { LAS const f32x2* stat = (LAS const f32x2*)(F.lds + MC_STAT);
      const f32x2 lg = *(const GAS f32x2*)(F.conv_ln_g + layer * DC + c0), lb = *(const GAS f32x2*)(F.conv_ln_b + layer * DC + c0);
      LAS unsigned char* ap = F.lds + MC_AIMG + (cp >> 2) * MC_ACH + (32 * th) * 16 + (cp & 3) * 4;
#pragma unroll
      for (int o = 0; o < 32; ++o) { const f32x2 st = stat[32 * th + o];
          const float h0 = (acc[o].x - st.x) * st.y * lg.x + lb.x, h1 = (acc[o].y - st.x) * st.y * lg.y + lb.y;
          *(LAS unsigned*)(ap + o * 16) = cvtpk(silu_f(h0), silu_f(h1)); } }
    __syncthreads();
    f32x16 pa[2][2];
#pragma unroll
    for (int nt = 0; nt < 2; ++nt)
#pragma unroll
        for (int tt = 0; tt < 2; ++tt) pa[nt][tt] = (f32x16){0.f, 0.f, 0.f, 0.f, 0.f, 0.f, 0.f, 0.f, 0.f, 0.f, 0.f, 0.f, 0.f, 0.f, 0.f, 0.f};
    { const int hi = lane >> 5, ql = lane & 31;
      const bf16* wp = F.wpw_t + (size_t)layer * DC * DC + (size_t)(64 * wave + ql) * DC + 8 * hi;
      LAS const unsigned char* ab = F.lds + MC_AIMG + hi * MC_ACH + ql * 16;
#pragma unroll 4
      for (int c = 0; c < 32; ++c) {
          const bf16x8 w0 = *(const GAS bf16x8*)(wp + 16 * c), w1 = *(const GAS bf16x8*)(wp + 32 * DC + 16 * c);
          const bf16x8 x0 = *(LAS const bf16x8*)(ab + c * 2 * MC_ACH), x1 = *(LAS const bf16x8*)(ab + c * 2 * MC_ACH + 512);
          pa[0][0] = MFMA32(w0, x0, pa[0][0]); pa[0][1] = MFMA32(w0, x1, pa[0][1]); pa[1][0] = MFMA32(w1, x0, pa[1][0]); pa[1][1] = MFMA32(w1, x1, pa[1][1]); }
#pragma unroll
      for (int tt = 0; tt < 2; ++tt) { const size_t row = (size_t)(b * SEQ + t0 + 32 * tt + ql);
          const bf16* gp = F.proj + row * DIN + C_CG + 64 * wave + 4 * hi; bf16* op = F.ymix + row * DM + Y_C + 64 * wave + 4 * hi;
#pragma unroll
          for (int nt = 0; nt < 2; ++nt)
#pragma unroll
              for (int g = 0; g < 4; ++g) { const int nn = 32 * nt + 8 * g; const v2u cg = *(const GAS v2u*)(gp + nn);
                  v2u o; o.x = pk2(pa[nt][tt][4 * g] * silu_f(bflo(cg.x)), pa[nt][tt][4 * g + 1] * silu_f(bfhi(cg.x)));
                  o.y = pk2(pa[nt][tt][4 * g + 2] * silu_f(bflo(cg.y)), pa[nt][tt][4 * g + 3] * silu_f(bfhi(cg.y)));
                  *(GAS v2u*)(op + nn) = o; } } }
    __syncthreads();
}
struct Args { const float* in[13]; float* out; unsigned char* ws; int ph_lo, ph_hi; };
constexpr int N_PHASES = 1 + 4 * DEPTH;
#ifndef MK_ONE_LAUNCH
#define MK_ONE_LAUNCH 1
#endif

constexpr int N_ITEMS_A = 128, N_ITEMS_B = 512, N_ITEMS_C = 256;
__device__ __forceinline__ void mixer_phase(Frame& F, int layer) {
    PHASE_IDS();
    volatile LAS unsigned* itemw = (volatile LAS unsigned*)(F.lds + MX_ITEM);
    unsigned* ctr = F.ctl + 64 * layer;
    for (;;) {
        if (tid == 0) *itemw = __hip_atomic_fetch_add(ctr, 1u, __ATOMIC_RELAXED, __HIP_MEMORY_SCOPE_AGENT);
        __syncthreads();
        const int item = (int)*itemw;
        __syncthreads();
        if (item >= N_ITEMS_A + N_ITEMS_B + N_ITEMS_C) break;
        if (item < N_ITEMS_A) mixer_a_item(F, layer, item, tid, wave, lane);
        else if (item < N_ITEMS_A + N_ITEMS_B) mixer_b_item(F, layer, item - N_ITEMS_A, tid, wave, lane);
        else mixer_c_item(F, layer, item - N_ITEMS_A - N_ITEMS_B, tid, wave, lane);
    }
    __syncthreads();
}

__global__ void __launch_bounds__(NWAVES * 64, 2) hymba_fwd(Args args) {
    extern __shared__ __attribute__((aligned(16))) unsigned char lds[];
    Frame F;
    F.lds = (LAS unsigned char*)lds;
    F.G = gridDim.x;
    unsigned char* ws = args.ws;
    F.x = args.in[0]; F.w_in = args.in[1]; F.diff_lambda = args.in[2]; F.head_gain = args.in[3]; F.conv_dw = args.in[4]; F.conv_b = args.in[5];
    F.conv_ln_g = args.in[6]; F.conv_ln_b = args.in[7]; F.conv_pw = args.in[8]; F.w_out = args.in[9]; F.ln_g = args.in[10]; F.ln_b = args.in[11]; F.rel_bias = args.in[12];
    F.out = args.out;
    F.win_t = (bf16*)(ws + WS_WIN); F.wout_t = (bf16*)(ws + WS_WOUT); F.wpw_t = (bf16*)(ws + WS_WPW); F.xb = (bf16*)(ws + WS_XB); F.ymix = (bf16*)(ws + WS_Y); F.proj = (bf16*)(ws + WS_PROJ);
    F.biasA = (float*)(ws + WS_TAB + TAB_BIASA); F.biasB = (float*)(ws + WS_TAB + TAB_BIASB); F.lamv = (float*)(ws + WS_TAB + TAB_LAM); F.ctl = (unsigned*)(ws + WS_CTL);
    const int lo = args.ph_lo, hi = args.ph_hi;
#define IN(k) (lo <= (k) && (k) < hi)
#if MK_ONE_LAUNCH
    cooperative_groups::grid_group grid = cooperative_groups::this_grid();
#define GRID_BAR() grid.sync()
#else
#define GRID_BAR() do {} while (0)
#endif
    if (IN(0)) { p0_prologue(F); if (IN(1)) GRID_BAR(); }
#pragma unroll
    for (int layer = 0; layer < DEPTH; ++layer) {
        const int p = 1 + 4 * layer;
        if (IN(p)) {
            pg8::Gemm g{F.xb, F.win_t + (size_t)layer * DIN * DM, MROWS, DIN, DM}; pg8::StaticOrder S; S.init(MROWS, DIN, F.G, (int)blockIdx.x);
            pg8::EpiBf16<0> E{F.proj, DIN, nullptr, 0, 0, 1.f};
            pg8::gemm_phase<pg8::EpiBf16<0>, pg8::StaticOrder, true, true>(F.lds, g, S, E);
            if (IN(p + 1)) GRID_BAR();
        }
        if (IN(p + 1)) {
            mixer_phase(F, layer);
            if (IN(p + 2)) GRID_BAR();
        }
        if (IN(p + 2)) {
            pg8::Gemm g{F.ymix, F.wout_t + (size_t)layer * DM * DM, MROWS, DM, DM}; pg8::StaticOrder S; S.init(MROWS, DM, F.G, (int)blockIdx.x);
            EpiResid E{layer == 0 ? F.x : F.out, F.out, DM, ALPHA};
            pg8::gemm_phase<EpiResid, pg8::StaticOrder, true, true>(F.lds, g, S, E);
            if (IN(p + 3)) GRID_BAR();
        }
        if (IN(p + 3)) {
            ln_phase(F, layer, layer + 1 < DEPTH);
            if (IN(p + 4)) GRID_BAR();
        }
    }
#undef IN
}

extern "C" void kernel_launch(void* const* d_in, const int* in_sizes, int n_in, void* d_out, int out_size, void* d_ws, size_t ws_size, hipStream_t stream) {
    static int grid = 0;
    if (grid == 0) {
        if (n_in != 13 || in_sizes[0] != MROWS * DM || out_size != MROWS * DM || ws_size < WS_END) { fprintf(stderr, "kernel_launch: unexpected shapes (n_in %d, in0 %d, out %d, ws %zu)\n", n_in, n_in > 0 ? in_sizes[0] : -1, out_size, ws_size); grid = -1; return; }
        int dev = 0, cus = 0, per_cu = 0;
        if (hipGetDevice(&dev) != hipSuccess || hipDeviceGetAttribute(&cus, hipDeviceAttributeMultiprocessorCount, dev) != hipSuccess) { grid = -1; return; }
        if (hipFuncSetAttribute((const void*)hymba_fwd, hipFuncAttributeMaxDynamicSharedMemorySize, LDS_BYTES) != hipSuccess) { fprintf(stderr, "kernel_launch: hipFuncSetAttribute failed\n"); grid = -1; return; }
        if (hipOccupancyMaxActiveBlocksPerMultiprocessor(&per_cu, (const void*)hymba_fwd, NWAVES * 64, LDS_BYTES) != hipSuccess || per_cu < 1) { fprintf(stderr, "kernel_launch: occupancy query says %d\n", per_cu); per_cu = 1; }
        (void)hipGetLastError();
        grid = cus;
    }
    if (grid < 0) return;
    if (hipMemsetAsync((char*)d_ws + WS_CTL, 0, CTL_ZERO_BYTES, stream) != hipSuccess) { fprintf(stderr, "kernel_launch: memset failed\n"); return; }
    Args a{};
    for (int i = 0; i < 13; ++i) a.in[i] = (const float*)d_in[i];
    a.out = (float*)d_out; a.ws = (unsigned char*)d_ws;
#if MK_ONE_LAUNCH
    a.ph_lo = 0; a.ph_hi = N_PHASES;
    void* kargs[] = {&a};
    hipError_t e = hipLaunchCooperativeKernel((const void*)hymba_fwd, dim3(grid), dim3(NWAVES * 64), kargs, LDS_BYTES, stream);
    if (e != hipSuccess) fprintf(stderr, "kernel_launch: cooperative launch failed: %s (grid %d)\n", hipGetErrorString(e), grid);
#else
    for (int ph = 0; ph < N_PHASES; ++ph) {
        a.ph_lo = ph; a.ph_hi = ph + 1;
        hipLaunchKernelGGL(hymba_fwd, dim3(grid), dim3(NWAVES * 64), LDS_BYTES, stream, a);
        const hipError_t le = hipPeekAtLastError();
        if (le != hipSuccess) { fprintf(stderr, "kernel_launch: launch %d failed: %s\n", ph, hipGetErrorName(le)); break; }
    }
#endif
}
```

```cpp
#include <hip/hip_runtime.h>
#include <hip/hip_cooperative_groups.h>
#include <cstdio>
#include <cstdint>
namespace pg8 {
#define PG8_LAS __attribute__((address_space(3)))
typedef unsigned short bf16_t;
typedef short bf16x8 __attribute__((ext_vector_type(8)));
typedef float f32x4 __attribute__((ext_vector_type(4)));
typedef unsigned u32x4 __attribute__((ext_vector_type(4)));
constexpr int BM = 256, BK = 64, HALF = 128, HTB = HALF * BK * 2  , STAGE_BYTES = 8 * HTB, NXCD = 8, WGM = 8;

__host__ __device__ __forceinline__ int lds_byte(int r, int c) { const int st = (r >> 4) * 2 + (c >> 5), rr = r & 15, cc = c & 31, ob = rr * 64 + cc * 2; return st * 1024 + (ob ^ (((ob >> 9) & 1) << 5)); }
__host__ __device__ __forceinline__ void stage_rc(int b, int& R, int& C) { const int st = b / 1024, sb = b % 1024, swz = sb ^ (((sb >> 9) & 1) << 5); R = (st >> 1) * 16 + swz / 64; C = (st & 1) * 32 + (swz % 64) / 2; }
__host__ __device__ __forceinline__ int perm32(int rho) { const int n = rho >> 4, i = rho & 15; return 8 * (i >> 2) + 4 * n + (i & 3); }

struct Unit { int pm, pn; };
struct Gemm { const bf16_t* A; const bf16_t* Bt; int M, N, K; };

struct StaticOrder {
    int nM, nN, nwg, G, c;
    __host__ __device__ void init(int M, int N, int G_, int c_) { nM = M / BM; nN = N / BM; nwg = nM * nN; G = G_; c = c_; }
    __host__ __device__ bool next(int i, Unit& u) const {
        const long L = (long)i * G + c; if (L >= nwg) return false;
        int wgid = (int)L; { const int q = nwg / NXCD, r = nwg % NXCD, xcd = wgid % NXCD, off = wgid / NXCD; wgid = (xcd < r ? xcd * (q + 1) : r * (q + 1) + (xcd - r) * q) + off; }
        const int nig = WGM * nN, gid = wgid / nig, fm = gid * WGM, gsz = (nM - fm) < WGM ? (nM - fm) : WGM;
        u.pm = fm + ((wgid % nig) % gsz); u.pn = (wgid % nig) / gsz; return true;
    }
    __device__ __forceinline__ void a_ready(const Unit&) const {}
    __device__ __forceinline__ void done(const Unit&) const {}
};

__device__ __forceinline__ unsigned cvt_pk_bf16(float lo, float hi) { unsigned r; asm volatile("v_cvt_pk_bf16_f32 %0, %1, %2" : "=v"(r) : "v"(lo), "v"(hi)); return r; }
typedef float f32x2 __attribute__((ext_vector_type(2)));
__device__ __forceinline__ f32x2 gelu_pk(f32x2 v) {
    const f32x2 av = __builtin_elementwise_abs(v), d = av * 0.2316418882f + 1.0f;
    f32x2 t; t.x = __builtin_amdgcn_rcpf(d.x); t.y = __builtin_amdgcn_rcpf(d.y);
    f32x2 q = t * 0.5307027145f + (-0.7265760135f); q = q * t + 0.7107068705f; q = q * t + (-0.142248368f); q = q * t + 0.127414796f; q = q * t;
    const f32x2 s = (v * v) * (-0.72134752044f);
    f32x2 e; e.x = __builtin_amdgcn_exp2f(s.x); e.y = __builtin_amdgcn_exp2f(s.y);
    const f32x2 m = v * (q * e), r = v - m;
    f32x2 o; o.x = v.x < 0.f ? m.x : r.x; o.y = v.y < 0.f ? m.y : r.y; return o;
}

template <int ACT  > struct EpiBf16 {
    static constexpr bool PERM = true, AFTER_DRAIN = false; static_assert(ACT == 0 || ACT == 1, "EpiBf16: ACT is 0 (none) or 1 (gelu_pk)");
    bf16_t* O; int ldc; const float* bias; int split_cols; size_t split_stride; float scale0;
    __device__ __forceinline__ void operator()(const f32x4 (&acc)[2][2][4][2], const Unit& u, int wr, int wc, int fr, int fq) const {
        const int row0 = u.pm * BM + wr * 64 + fr; int colt = u.pn * BM; bf16_t* base = O;
        float sc = 1.f; if (split_cols) { const int t = colt / split_cols; base += (size_t)t * split_stride; colt -= t * split_cols; if (t == 0) sc = scale0; }
        const int col0 = colt + wc * 32 + 8 * fq, bcol0 = u.pn * BM + wc * 32 + 8 * fq;
        f32x4 bv[2][2];
#pragma unroll
        for (int bj = 0; bj < 2; ++bj)
#pragma unroll
            for (int n = 0; n < 2; ++n) bv[bj][n] = bias ? *(const f32x4*)(bias + bcol0 + bj * HALF + 4 * n) : (f32x4){0.f, 0.f, 0.f, 0.f};
#pragma unroll
        for (int ai = 0; ai < 2; ++ai)
#pragma unroll
            for (int m = 0; m < 4; ++m) { bf16_t* rowp = base + (size_t)(row0 + ai * HALF + m * 16) * ldc + col0;
#pragma unroll
                for (int bj = 0; bj < 2; ++bj) { f32x4 v0 = acc[ai][bj][m][0] + bv[bj][0], v1 = acc[ai][bj][m][1] + bv[bj][1];
                    if (ACT == 1) { f32x2 a = gelu_pk((f32x2){v0[0], v0[1]}), b = gelu_pk((f32x2){v0[2], v0[3]}), c = gelu_pk((f32x2){v1[0], v1[1]}), d = gelu_pk((f32x2){v1[2], v1[3]});
                        v0 = (f32x4){a.x, a.y, b.x, b.y}; v1 = (f32x4){c.x, c.y, d.x, d.y}; }
                    v0 = v0 * sc; v1 = v1 * sc; u32x4 w; w.x = cvt_pk_bf16(v0[0], v0[1]); w.y = cvt_pk_bf16(v0[2], v0[3]); w.z = cvt_pk_bf16(v1[0], v1[1]); w.w = cvt_pk_bf16(v1[2], v1[3]);
                    *(u32x4*)(rowp + bj * HALF) = w; } }
    }
};

template <class Epi, class Sched, bool ALIGN_EPI = false, bool SP2 = false>
__device__ __forceinline__ void gemm_phase(PG8_LAS unsigned char* lds, const Gemm g, const Sched& S, const Epi& E, int wave_in) {
    int tid_ = wave_in * 64 + (int)__builtin_amdgcn_mbcnt_hi(~0u, __builtin_amdgcn_mbcnt_lo(~0u, 0u)); asm volatile("" : "+v"(tid_));
    const int tid = tid_, wid = __builtin_amdgcn_readfirstlane(tid >> 6), lane = tid & 63, wr = wid >> 2, wc = wid & 3, fr = lane & 15, fq = lane >> 4;
    const int K = g.K, nt = K / BK;
    unsigned voffA[2], voffB[2];
#pragma unroll
    for (int i = 0; i < 2; ++i) { int R, C; stage_rc(tid * 16 + i * 8192, R, C); const int Rb = Epi::PERM ? ((R & ~31) + perm32(R & 31)) : R;
        voffA[i] = (unsigned)(R * K + C) * 2u; voffB[i] = (unsigned)(Rb * K + C) * 2u; }
    const size_t kstep = (size_t)(BK * 2);
    const size_t hstep = (size_t)HALF * K * 2;
    const size_t tstep = 2 * hstep;
    const unsigned ldsw = (unsigned)wid * 1024u;
    const int aoff = lds_byte(wr * 64 + fr, fq * 8), boff = lds_byte(wc * 32 + fr, fq * 8);
#define PG8_SA(b, h) (((b) * 2 + (h)) * HTB)
#define PG8_SB(b, h) ((4 + (b) * 2 + (h)) * HTB)
#define PG8_STAGE(bufoff, gbase, voff) do { _Pragma("unroll") for (int _i = 0; _i < 2; ++_i) \
        __builtin_amdgcn_global_load_lds((const unsigned*)((const char*)(gbase) + (voff)[_i]), (PG8_LAS unsigned*)(lds + (bufoff) + ldsw + _i * 8192), 16, 0, 0); } while (0)
#define PG8_LDA(dst, b, h) do { _Pragma("unroll") for (int m = 0; m < 4; ++m) _Pragma("unroll") for (int k = 0; k < 2; ++k) dst[m][k] = *(const PG8_LAS bf16x8*)(lds + PG8_SA(b, h) + aoff + m * 2048 + k * 1024); } while (0)
#define PG8_LDB(dst, b, h) do { _Pragma("unroll") for (int n = 0; n < 2; ++n) _Pragma("unroll") for (int k = 0; k < 2; ++k) dst[n][k] = *(const PG8_LAS bf16x8*)(lds + PG8_SB(b, h) + boff + n * 2048 + k * 1024); } while (0)
#define PG8_MMA(ai, bj, At, Bt) do { __builtin_amdgcn_s_setprio(1); _Pragma("unroll") for (int m = 0; m < 4; ++m) _Pragma("unroll") for (int n = 0; n < 2; ++n) _Pragma("unroll") for (int k = 0; k < 2; ++k) \
        acc[ai][bj][m][n] = __builtin_amdgcn_mfma_f32_16x16x32_bf16(Bt[n][k], At[m][k], acc[ai][bj][m][n], 0, 0, 0); __builtin_amdgcn_s_setprio(0); } while (0)
#define PG8_WAIT_V(n) asm volatile("s_waitcnt vmcnt(" #n ")" ::: "memory")
#define PG8_WAIT_L(n) asm volatile("s_waitcnt lgkmcnt(" #n ")" ::: "memory")
#define PG8_BAR __builtin_amdgcn_s_barrier()
#define PG8_SCHED __builtin_amdgcn_sched_barrier(0)
    Unit cur, nxt; int ui = 0;
    if (!S.next(0, cur)) return;
    f32x4 acc[2][2][4][2];
#pragma unroll
    for (int a = 0; a < 2; ++a)
#pragma unroll
        for (int b = 0; b < 2; ++b)
#pragma unroll
            for (int m = 0; m < 4; ++m)
#pragma unroll
                for (int n = 0; n < 2; ++n) acc[a][b][m][n] = (f32x4){0.f, 0.f, 0.f, 0.f};
    bf16x8 At[4][2], B0[2][2], B1[2][2];
    const char* cA = (const char*)g.A + (size_t)cur.pm * tstep; const char* cB = (const char*)g.Bt + (size_t)cur.pn * tstep;
    S.a_ready(cur);
    if constexpr (SP2) {
        PG8_STAGE(PG8_SB(0, 0), cB, voffB); PG8_STAGE(PG8_SB(0, 1), cB + hstep, voffB); PG8_STAGE(PG8_SA(0, 0), cA, voffA); PG8_STAGE(PG8_SA(0, 1), cA + hstep, voffA);
        if (wr == 1) PG8_BAR;
        PG8_WAIT_V(2); PG8_BAR;
        PG8_STAGE(PG8_SB(1, 0), cB + kstep, voffB); PG8_STAGE(PG8_SA(1, 0), cA + kstep, voffA); PG8_STAGE(PG8_SB(1, 1), cB + hstep + kstep, voffB);
        PG8_WAIT_V(6); PG8_BAR;
    } else {
        PG8_STAGE(PG8_SB(0, 0), cB, voffB); PG8_STAGE(PG8_SA(0, 0), cA, voffA); PG8_STAGE(PG8_SB(0, 1), cB + hstep, voffB); PG8_STAGE(PG8_SA(0, 1), cA + hstep, voffA);
        if (wr == 1) PG8_BAR;
        PG8_WAIT_V(4); PG8_BAR;
        PG8_STAGE(PG8_SB(1, 0), cB + kstep, voffB); PG8_STAGE(PG8_SA(1, 0), cA + kstep, voffA); PG8_STAGE(PG8_SB(1, 1), cB + hstep + kstep, voffB);
        PG8_WAIT_V(6); PG8_BAR;
    }
    for (;;) {
        const bool has_next = S.next(ui + 1, nxt);
        const char* nA = has_next ? (const char*)g.A + (size_t)nxt.pm * tstep : cA; const char* nB = has_next ? (const char*)g.Bt + (size_t)nxt.pn * tstep : cB;
        for (int t = 0; t < nt; t += 2) {
            const bool last = (t == nt - 2);
            const char* a1 = cA + (size_t)(t + 1) * kstep;
            const char* a2 = last ? nA : cA + (size_t)(t + 2) * kstep; const char* b2 = last ? nB : cB + (size_t)(t + 2) * kstep;
            const char* a3 = a2 + kstep; const char* b3 = b2 + kstep;
            if (last && has_next) S.a_ready(nxt);
            if constexpr (SP2) {
            PG8_LDB(B0, 0, 0); PG8_LDB(B1, 0, 1); PG8_SCHED; PG8_LDA(At, 0, 0); PG8_STAGE(PG8_SA(1, 1), a1 + hstep, voffA);
            PG8_WAIT_V(8); PG8_WAIT_L(0); PG8_BAR; PG8_MMA(0, 0, At, B0); PG8_MMA(0, 1, At, B1); PG8_BAR; PG8_SCHED;
            PG8_LDA(At, 0, 1); PG8_STAGE(PG8_SB(0, 0), b2, voffB); PG8_STAGE(PG8_SB(0, 1), b2 + hstep, voffB); PG8_STAGE(PG8_SA(0, 0), a2, voffA);
            PG8_WAIT_V(8); PG8_WAIT_L(0); PG8_BAR; PG8_MMA(1, 0, At, B0); PG8_MMA(1, 1, At, B1); PG8_BAR; PG8_SCHED;
            PG8_LDB(B0, 1, 0); PG8_LDB(B1, 1, 1); PG8_SCHED; PG8_LDA(At, 1, 0); PG8_STAGE(PG8_SA(0, 1), a2 + hstep, voffA);
            PG8_WAIT_V(8); PG8_WAIT_L(0); PG8_BAR; PG8_MMA(0, 0, At, B0); PG8_MMA(0, 1, At, B1); PG8_BAR; PG8_SCHED;
            PG8_LDA(At, 1, 1); PG8_STAGE(PG8_SB(1, 0), b3, voffB); PG8_STAGE(PG8_SB(1, 1), b3 + hstep, voffB); PG8_STAGE(PG8_SA(1, 0), a3, voffA);
            PG8_WAIT_V(8); PG8_WAIT_L(0); PG8_BAR; PG8_MMA(1, 0, At, B0); PG8_MMA(1, 1, At, B1); PG8_BAR; PG8_SCHED;
            } else {
            PG8_LDB(B0, 0, 0); PG8_SCHED; PG8_LDA(At, 0, 0); PG8_STAGE(PG8_SA(1, 1), a1 + hstep, voffA);
            PG8_WAIT_L(8); PG8_BAR; PG8_WAIT_L(0); PG8_MMA(0, 0, At, B0); PG8_BAR; PG8_SCHED;
            PG8_LDB(B1, 0, 1); PG8_STAGE(PG8_SB(0, 0), b2, voffB);
            PG8_BAR; PG8_WAIT_L(0); PG8_MMA(0, 1, At, B1); PG8_BAR;
            PG8_LDA(At, 0, 1); PG8_STAGE(PG8_SA(0, 0), a2, voffA);
            PG8_BAR; PG8_WAIT_L(0); PG8_MMA(1, 0, At, B0); PG8_BAR; PG8_SCHED;
            PG8_STAGE(PG8_SB(0, 1), b2 + hstep, voffB);
            PG8_WAIT_V(6); PG8_BAR; PG8_MMA(1, 1, At, B1); PG8_BAR;
            PG8_LDB(B0, 1, 0); PG8_SCHED; PG8_LDA(At, 1, 0); PG8_STAGE(PG8_SA(0, 1), a2 + hstep, voffA);
            PG8_WAIT_L(8); PG8_BAR; PG8_WAIT_L(0); PG8_MMA(0, 0, At, B0); PG8_BAR; PG8_SCHED;
            PG8_LDB(B1, 1, 1); PG8_STAGE(PG8_SB(1, 0), b3, voffB);
            PG8_BAR; PG8_WAIT_L(0); PG8_MMA(0, 1, At, B1); PG8_BAR;
            PG8_LDA(At, 1, 1); PG8_STAGE(PG8_SA(1, 0), a3, voffA);
            PG8_BAR; PG8_WAIT_L(0); PG8_MMA(1, 0, At, B0); PG8_BAR; PG8_SCHED;
            PG8_STAGE(PG8_SB(1, 1), b3 + hstep, voffB);
            PG8_WAIT_V(6); PG8_BAR; PG8_MMA(1, 1, At, B1); PG8_BAR;
            }
        }
        if constexpr (ALIGN_EPI) { if (wr == 0) PG8_BAR; }
        if constexpr (!Epi::AFTER_DRAIN) { E(acc, cur, wr, wc, fr, fq); S.done(cur); }
        if (!has_next) break;
#pragma unroll
        for (int a = 0; a < 2; ++a)
#pragma unroll
            for (int b = 0; b < 2; ++b)
#pragma unroll
                for (int m = 0; m < 4; ++m)
#pragma unroll
                    for (int n = 0; n < 2; ++n) acc[a][b][m][n] = (f32x4){0.f, 0.f, 0.f, 0.f};
        cur = nxt; cA = nA; cB = nB; ++ui;
        if constexpr (ALIGN_EPI) { if (wr == 1) PG8_BAR; }
    }
    PG8_WAIT_V(0);
    if constexpr (!ALIGN_EPI) { if (wr == 0) PG8_BAR; }
    PG8_BAR;
    if constexpr (Epi::AFTER_DRAIN) { E.fused(acc, cur, wr, wc, fr, fq, lds, wid, lane); S.done(cur); }
#undef PG8_SA
#undef PG8_SB
#undef PG8_STAGE
#undef PG8_LDA
#undef PG8_LDB
#undef PG8_MMA
#undef PG8_WAIT_V
#undef PG8_WAIT_L
#undef PG8_BAR
#undef PG8_SCHED
}
}

constexpr int BATCH = 8, SEQ = 2048, DM = 2048, MROWS = BATCH * SEQ, DIN = 7680, DEPTH = 2;
constexpr int C_AQ = 0, C_AK = 512, C_AV = 1024, C_AG = 1536, C_BQ = 2048, C_BK = 3072, C_BV = 4096, C_BG = 5120, C_CU = 6144, C_CGLU = 6656, C_CG = 7168;
constexpr int Y_A = 0, Y_B = 512, Y_C = 1536;
constexpr int DC = 512, CONVW = 31;
constexpr float LN_EPS = 1e-5f;
constexpr float ALPHA = 1.41421356237309515f;
constexpr int NWAVES = 8;
constexpr int LDS_BYTES = 163840;

constexpr size_t MiB = 1u << 20;
constexpr size_t WS_CTL = 0, CTL_ZERO_BYTES = 64 * 1024;
constexpr size_t WS_TAB = 1 * MiB;
constexpr size_t TAB_BIASA = 0, TAB_BIASB = 32 * 1024, TAB_LAM = 64 * 1024;
constexpr size_t WS_WIN = 2 * MiB;
constexpr size_t WS_WOUT = 62 * MiB;
constexpr size_t WS_WPW = 78 * MiB;
constexpr size_t WS_XB = 80 * MiB;
constexpr size_t WS_Y = 144 * MiB;
constexpr size_t WS_PROJ = 208 * MiB;
constexpr size_t WS_BST = 448 * MiB;
constexpr size_t WS_END = 448 * MiB + 256 * (size_t)(256 * 528);

#define GAS __attribute__((address_space(1)))
#define LAS __attribute__((address_space(3)))
typedef unsigned short bf16;
typedef unsigned v4u __attribute__((ext_vector_type(4)));
typedef unsigned v2u __attribute__((ext_vector_type(2)));
typedef float f32x4 __attribute__((ext_vector_type(4)));
#define LDS_WAIT() asm volatile("s_waitcnt lgkmcnt(0)" ::: "memory")
#define VM_WAIT() asm volatile("s_waitcnt vmcnt(0)" ::: "memory")

__device__ __forceinline__ unsigned f2bf(float f) { unsigned u = __builtin_bit_cast(unsigned, f); return (u + 0x7fffu + ((u >> 16) & 1u)) >> 16; }
__device__ __forceinline__ unsigned pk2(float lo, float hi) { return f2bf(lo) | (f2bf(hi) << 16); }
__device__ __forceinline__ float bflo(unsigned u) { return __uint_as_float(u << 16); }
__device__ __forceinline__ float bfhi(unsigned u) { return __uint_as_float(u & 0xffff0000u); }
template <int CTRL> __device__ __forceinline__ float dpp_f(float v) { return __uint_as_float((unsigned)__builtin_amdgcn_mov_dpp((int)__float_as_uint(v), CTRL, 0xF, 0xF, true)); }
#define DPP_XOR1 0xB1
#define DPP_XOR2 0x4E
#define DPP_HMIR 0x141
#define DPP_RMIR 0x140
__device__ __forceinline__ float xor16_sum(float v) { auto r = __builtin_amdgcn_permlane16_swap(__float_as_uint(v), __float_as_uint(v), false, false); return __uint_as_float(r[0]) + __uint_as_float(r[1]); }
__device__ __forceinline__ float xor32_sum(float v) { auto r = __builtin_amdgcn_permlane32_swap(__float_as_uint(v), __float_as_uint(v), false, false); return __uint_as_float(r[0]) + __uint_as_float(r[1]); }
__device__ __forceinline__ float xor16_max(float v) { auto r = __builtin_amdgcn_permlane16_swap(__float_as_uint(v), __float_as_uint(v), false, false); return fmaxf(__uint_as_float(r[0]), __uint_as_float(r[1])); }
__device__ __forceinline__ float xor32_max(float v) { auto r = __builtin_amdgcn_permlane32_swap(__float_as_uint(v), __float_as_uint(v), false, false); return fmaxf(__uint_as_float(r[0]), __uint_as_float(r[1])); }
__device__ __forceinline__ float quad_sum(float v) { v += dpp_f<DPP_XOR1>(v); v += dpp_f<DPP_XOR2>(v); return v; }
__device__ __forceinline__ float oct_sum(float v) { v = quad_sum(v); v += dpp_f<DPP_HMIR>(v); return v; }
__device__ __forceinline__ float wave_sum(float v) { v = oct_sum(v); v += dpp_f<DPP_RMIR>(v); v = xor16_sum(v); return xor32_sum(v); }
__device__ __forceinline__ float wave_max(float v) {
    v = fmaxf(v, dpp_f<DPP_XOR1>(v)); v = fmaxf(v, dpp_f<DPP_XOR2>(v)); v = fmaxf(v, dpp_f<DPP_HMIR>(v)); v = fmaxf(v, dpp_f<DPP_RMIR>(v)); v = xor16_max(v); return xor32_max(v);
}
__device__ __forceinline__ float dot8(v4u a, v4u b, float s) {
    s += bflo(a.x) * bflo(b.x); s += bfhi(a.x) * bfhi(b.x); s += bflo(a.y) * bflo(b.y); s += bfhi(a.y) * bfhi(b.y);
    s += bflo(a.z) * bflo(b.z); s += bfhi(a.z) * bfhi(b.z); s += bflo(a.w) * bflo(b.w); s += bfhi(a.w) * bfhi(b.w);
    return s;
}
__device__ __forceinline__ float silu_f(float x) { return x / (1.f + __expf(-x)); }
__device__ __forceinline__ float sigmoid_f(float x) { return 1.f / (1.f + __expf(-x)); }
__device__ __forceinline__ int t5_bucket(int d) {
    if (d < 16) return d;
    int v = 16 + (int)(logf((float)d * (1.f / 16.f)) / 4.852030263919617f * 16.f);
    return v < 31 ? v : 31;
}
__host__ __device__ __forceinline__ float lam_init_of(int layer) { return layer == 0 ? 0.2f : 0.35550906759f; }

struct EpiResid {
    static constexpr bool PERM = false, AFTER_DRAIN = false;
    const float* res; float* out; int ldc; float alpha;
    __device__ __forceinline__ void operator()(const pg8::f32x4 (&acc)[2][2][4][2], const pg8::Unit& u, int wr, int wc, int fr, int fq) const {
        const int row0 = u.pm * pg8::BM + wr * 64 + fr, col0 = u.pn * pg8::BM + wc * 32 + 4 * fq;
#pragma unroll
        for (int ai = 0; ai < 2; ++ai)
#pragma unroll
            for (int m = 0; m < 4; ++m) { const size_t off = (size_t)(row0 + ai * pg8::HALF + m * 16) * ldc + col0;
                pg8::f32x4 r[2][2];
#pragma unroll
                for (int bj = 0; bj < 2; ++bj)
#pragma unroll
                    for (int n = 0; n < 2; ++n) r[bj][n] = *(const pg8::f32x4*)(res + off + bj * pg8::HALF + n * 16);
#pragma unroll
                for (int bj = 0; bj < 2; ++bj)
#pragma unroll
                    for (int n = 0; n < 2; ++n) *(pg8::f32x4*)(out + off + bj * pg8::HALF + n * 16) = r[bj][n] * alpha + acc[ai][bj][m][n];
                asm volatile("" ::: "memory"); }
    }
};

struct Frame {
    LAS unsigned char* lds;
    int G, wave;
    const float *x, *w_in, *diff_lambda, *head_gain, *conv_dw, *conv_b, *conv_ln_g, *conv_ln_b, *conv_pw, *w_out, *ln_g, *ln_b, *rel_bias;
    float* out;
    bf16 *win_t, *wout_t, *wpw_t, *xb, *ymix, *proj;
    float *biasA, *biasB, *lamv;
    unsigned* ctl;
    unsigned char* bstate;
};

#define PHASE_IDS() int wave_ = F.wave; asm volatile("" : "+s"(wave_)); int lane_ = (int)__builtin_amdgcn_mbcnt_hi(~0u, __builtin_amdgcn_mbcnt_lo(~0u, 0u)); asm volatile("" : "+v"(lane_)); const int wave = wave_, lane = lane_, tid = wave * 64 + lane; (void)tid; (void)lane; (void)wave
__device__ __forceinline__ void p0_transpose_item(const float* W, int K, int N, bf16* WT, LAS float* scr, int item, int lane) {
    const int nblk = N / 32, kb = item / nblk, nb = item % nblk, k0 = 64 * kb, n0 = 32 * nb;
#pragma unroll 8
    for (int i = 0; i < 32; ++i) { const int kk = 2 * i + (lane >> 5); scr[kk * 33 + (lane & 31)] = W[(size_t)(k0 + kk) * N + n0 + (lane & 31)]; }
    LDS_WAIT(); asm volatile("" ::: "memory");
    const int c = lane & 7;
#pragma unroll
    for (int j = 0; j < 4; ++j) { const int n = (lane >> 3) + 8 * j; const LAS float* s = scr + (8 * c) * 33 + n;
        v4u o; o.x = pk2(s[0 * 33], s[1 * 33]); o.y = pk2(s[2 * 33], s[3 * 33]); o.z = pk2(s[4 * 33], s[5 * 33]); o.w = pk2(s[6 * 33], s[7 * 33]);
        *(GAS v4u*)(WT + (size_t)(n0 + n) * K + k0 + 8 * c) = o; }
    LDS_WAIT(); asm volatile("" ::: "memory");
}

__device__ __forceinline__ void p0_prologue(Frame& F) {
    PHASE_IDS();
    LAS float* scr = (LAS float*)(F.lds + wave * 16384);
    const int gw = blockIdx.x * NWAVES + wave, NGW = F.G * NWAVES;
    constexpr int I_IN = (DM / 64) * (DIN / 32), I_OUT = (DM / 64) * (DM / 32), I_PW = (DC / 64) * (DC / 32);
    constexpr int NITEMS = DEPTH * (I_IN + I_OUT + I_PW);
    for (int it = gw; it < NITEMS; it += NGW) {
        int r = it;
        if (r < DEPTH * I_IN) { const int l = r / I_IN; r -= l * I_IN; p0_transpose_item(F.w_in + (size_t)l * DM * DIN, DM, DIN, F.win_t + (size_t)l * DIN * DM, scr, r, lane); continue; }
        r -= DEPTH * I_IN;
        if (r < DEPTH * I_OUT) { const int l = r / I_OUT; r -= l * I_OUT; p0_transpose_item(F.w_out + (size_t)l * DM * DM, DM, DM, F.wout_t + (size_t)l * DM * DM, scr, r, lane); continue; }
        r -= DEPTH * I_OUT;
        { const int l = r / I_PW; r -= l * I_PW; p0_transpose_item(F.conv_pw + (size_t)l * DC * DC, DC, DC, F.wpw_t + (size_t)l * DC * DC, scr, r, lane); }
    }
    { const size_t n8 = (size_t)MROWS * DM / 8;
      for (size_t i = (size_t)gw * 64 + lane; i < n8; i += (size_t)NGW * 64) {
          const f32x4 a = *(const GAS f32x4*)(F.x + i * 8), b = *(const GAS f32x4*)(F.x + i * 8 + 4);
          v4u o; o.x = pk2(a.x, a.y); o.y = pk2(a.z, a.w); o.z = pk2(b.x, b.y); o.w = pk2(b.z, b.w);
          *(GAS v4u*)(F.xb + i * 8) = o; } }
    { const int gt = blockIdx.x * (NWAVES * 64) + tid, NT = F.G * NWAVES * 64;
      for (int i = gt; i < 4 * 2048; i += NT) { const int h = i >> 11, d = i & 2047; F.biasA[i] = F.rel_bias[t5_bucket(d) * 12 + h]; }
      for (int i = gt; i < 3 * 8 * 132; i += NT) { const int p = i / (8 * 132), h = (i / 132) % 8, j = i % 132; const int dil = p == 0 ? 1 : (p == 1 ? 4 : 16);
          F.biasB[i] = (j <= 128) ? F.rel_bias[t5_bucket(j * dil) * 12 + 4 + h] : 0.f; }
      if (gt < DEPTH) { const float* lv = F.diff_lambda + gt * 4 * 64; float s0 = 0.f, s1 = 0.f;
          for (int i = 0; i < 64; ++i) { s0 += lv[i] * lv[64 + i]; s1 += lv[128 + i] * lv[192 + i]; }
          F.lamv[gt] = expf(s0) - expf(s1) + lam_init_of(gt); } }
}

__device__ __forceinline__ void naive_mixer_a(Frame& F, int layer) {
    PHASE_IDS();
    LAS float* sc = (LAS float*)(F.lds) + wave * 4096;
    const float lam = F.lamv[layer], li = lam_init_of(layer);
    const int gw = blockIdx.x * NWAVES + wave, NGW = F.G * NWAVES;
    for (int item = gw; item < MROWS * 4; item += NGW) {
        const int h = item & 3, bt = item >> 2, t = bt & (SEQ - 1), b = bt >> 11;
        const bf16* base = F.proj + (size_t)(b * SEQ) * DIN;
        const bf16* qp = base + (size_t)t * DIN + C_AQ + h * 128;
        v4u q[16];
#pragma unroll
        for (int i = 0; i < 16; ++i) q[i] = *(const GAS v4u*)(qp + i * 8);
        float m0 = -INFINITY, m1 = -INFINITY;
        for (int k = lane; k <= t; k += 64) {
            const bf16* kp = base + (size_t)k * DIN + C_AK + h * 128;
            float s0 = 0.f, s1 = 0.f;
#pragma unroll
            for (int i = 0; i < 8; ++i) s0 = dot8(q[i], *(const GAS v4u*)(kp + i * 8), s0);
#pragma unroll
            for (int i = 8; i < 16; ++i) s1 = dot8(q[i], *(const GAS v4u*)(kp + i * 8), s1);
            const float bias = F.biasA[h * 2048 + (t - k)];
            s0 = s0 * 0.125f + bias; s1 = s1 * 0.125f + bias;
            sc[k] = s0; sc[2048 + k] = s1; m0 = fmaxf(m0, s0); m1 = fmaxf(m1, s1);
        }
        m0 = wave_max(m0); m1 = wave_max(m1);
        float l0 = 0.f, l1 = 0.f;
        for (int k = lane; k <= t; k += 64) { const float p0 = __expf(sc[k] - m0), p1 = __expf(sc[2048 + k] - m1); sc[k] = p0; sc[2048 + k] = p1; l0 += p0; l1 += p1; }
        l0 = wave_sum(l0); l1 = wave_sum(l1);
        const float i0 = 1.f / l0, i1 = lam / l1;
        for (int k = lane; k <= t; k += 64) sc[k] = sc[k] * i0 - sc[2048 + k] * i1;
        LDS_WAIT(); asm volatile("" ::: "memory");
        float a0 = 0.f, a1 = 0.f;
        const bf16* vp = base + C_AV + h * 128 + 2 * lane;
        for (int k = 0; k <= t; ++k) { const float a = sc[k]; const unsigned v = *(const GAS unsigned*)(vp + (size_t)k * DIN); a0 += a * bflo(v); a1 += a * bfhi(v); }
        const float ss = wave_sum(a0 * a0 + a1 * a1);
        const float r = rsqrtf(ss * (1.f / 128.f) + LN_EPS) * (1.f - li);
        const float g0 = F.head_gain[layer * 128 + 2 * lane], g1 = F.head_gain[layer * 128 + 2 * lane + 1];
        const unsigned ag = *(const GAS unsigned*)(base + (size_t)t * DIN + C_AG + h * 128 + 2 * lane);
        const float o0 = a0 * r * g0 * silu_f(bflo(ag)), o1 = a1 * r * g1 * silu_f(bfhi(ag));
        *(GAS unsigned*)(F.ymix + (size_t)(b * SEQ + t) * DM + Y_A + h * 128 + 2 * lane) = pk2(o0, o1);
        LDS_WAIT(); asm volatile("" ::: "memory");
    }
}

__device__ __forceinline__ void naive_mixer_b(Frame& F, int layer) {
    PHASE_IDS();
    LAS float* sc = (LAS float*)(F.lds) + wave * 512;
    const int gw = blockIdx.x * NWAVES + wave, NGW = F.G * NWAVES;
    const float scale = 0.08838834764831845f;
    for (int item = gw; item < MROWS * 8; item += NGW) {
        const int h = item & 7, bt = item >> 3, t = bt & (SEQ - 1), b = bt >> 11;
        const bf16* base = F.proj + (size_t)(b * SEQ) * DIN;
        const bf16* qp = base + (size_t)t * DIN + C_BQ + h * 128;
        v4u q[16];
#pragma unroll
        for (int i = 0; i < 16; ++i) q[i] = *(const GAS v4u*)(qp + i * 8);
        float m = -INFINITY;
#pragma unroll
        for (int p = 0; p < 3; ++p) { const int dil = p == 0 ? 1 : (p == 1 ? 4 : 16);
            for (int j = lane; j <= 128; j += 64) { const int tk = t - j * dil; float s = -INFINITY;
                if (tk >= 0) { const bf16* kp = base + (size_t)tk * DIN + C_BK + h * 128; s = 0.f;
#pragma unroll
                    for (int i = 0; i < 16; ++i) s = dot8(q[i], *(const GAS v4u*)(kp + i * 8), s);
                    s = s * scale + F.biasB[(p * 8 + h) * 132 + j]; }
                sc[p * 132 + j] = s; m = fmaxf(m, s); } }
        m = wave_max(m);
        float l = 0.f;
#pragma unroll
        for (int p = 0; p < 3; ++p) for (int j = lane; j <= 128; j += 64) { const float e = __expf(sc[p * 132 + j] - m); sc[p * 132 + j] = e; l += e; }
        l = wave_sum(l);
        LDS_WAIT(); asm volatile("" ::: "memory");
        float a0 = 0.f, a1 = 0.f;
        const bf16* vp = base + C_BV + h * 128 + 2 * lane;
#pragma unroll
        for (int p = 0; p < 3; ++p) { const int dil = p == 0 ? 1 : (p == 1 ? 4 : 16); int jmax = t / dil; jmax = jmax < 128 ? jmax : 128;
            for (int j = 0; j <= jmax; ++j) { const float a = sc[p * 132 + j]; const unsigned v = *(const GAS unsigned*)(vp + (size_t)(t - j * dil) * DIN); a0 += a * bflo(v); a1 += a * bfhi(v); } }
        const float il = 1.f / l;
        const unsigned bg = *(const GAS unsigned*)(base + (size_t)t * DIN + C_BG + h * 128 + 2 * lane);
        *(GAS unsigned*)(F.ymix + (size_t)(b * SEQ + t) * DM + Y_B + h * 128 + 2 * lane) = pk2(a0 * il * silu_f(bflo(bg)), a1 * il * silu_f(bfhi(bg)));
        LDS_WAIT(); asm volatile("" ::: "memory");
    }
}

__device__ __forceinline__ void naive_mixer_c(Frame& F, int layer) {
    PHASE_IDS();
    LAS float* hb = (LAS float*)(F.lds) + wave * 512;
    const int gw = blockIdx.x * NWAVES + wave, NGW = F.G * NWAVES, c0 = lane * 8;
    const float* dw = F.conv_dw + (size_t)layer * CONVW * DC; const float* pw = F.conv_pw + (size_t)layer * DC * DC;
    for (int item = gw; item < MROWS; item += NGW) {
        const int t = item & (SEQ - 1), b = item >> 11;
        const bf16* base = F.proj + (size_t)(b * SEQ) * DIN;
        float acc[8];
#pragma unroll
        for (int i = 0; i < 8; ++i) acc[i] = F.conv_b[layer * DC + c0 + i];
        for (int j = 0; j < CONVW; ++j) { const int tk = t - (CONVW - 1) + j; if (tk < 0) continue;
            const v4u u = *(const GAS v4u*)(base + (size_t)tk * DIN + C_CU + c0), g = *(const GAS v4u*)(base + (size_t)tk * DIN + C_CGLU + c0);
            const f32x4 w0 = *(const GAS f32x4*)(dw + j * DC + c0), w1 = *(const GAS f32x4*)(dw + j * DC + c0 + 4);
            acc[0] += w0.x * (bflo(u.x) * sigmoid_f(bflo(g.x))); acc[1] += w0.y * (bfhi(u.x) * sigmoid_f(bfhi(g.x)));
            acc[2] += w0.z * (bflo(u.y) * sigmoid_f(bflo(g.y))); acc[3] += w0.w * (bfhi(u.y) * sigmoid_f(bfhi(g.y)));
            acc[4] += w1.x * (bflo(u.z) * sigmoid_f(bflo(g.z))); acc[5] += w1.y * (bfhi(u.z) * sigmoid_f(bfhi(g.z)));
            acc[6] += w1.z * (bflo(u.w) * sigmoid_f(bflo(g.w))); acc[7] += w1.w * (bfhi(u.w) * sigmoid_f(bfhi(g.w))); }
        float s = 0.f;
#pragma unroll
        for (int i = 0; i < 8; ++i) s += acc[i];
        const float mean = wave_sum(s) * (1.f / DC); float s2 = 0.f;
#pragma unroll
        for (int i = 0; i < 8; ++i) { acc[i] -= mean; s2 += acc[i] * acc[i]; }
        const float rstd = rsqrtf(wave_sum(s2) * (1.f / DC) + LN_EPS);
#pragma unroll
        for (int i = 0; i < 8; ++i) { const float hn = acc[i] * rstd * F.conv_ln_g[layer * DC + c0 + i] + F.conv_ln_b[layer * DC + c0 + i]; hb[c0 + i] = silu_f(hn); }
        LDS_WAIT(); asm volatile("" ::: "memory");
        float o[8];
#pragma unroll
        for (int i = 0; i < 8; ++i) o[i] = 0.f;
        for (int c = 0; c < DC; ++c) { const float hv = hb[c]; const f32x4 w0 = *(const GAS f32x4*)(pw + (size_t)c * DC + c0), w1 = *(const GAS f32x4*)(pw + (size_t)c * DC + c0 + 4);
            o[0] += hv * w0.x; o[1] += hv * w0.y; o[2] += hv * w0.z; o[3] += hv * w0.w; o[4] += hv * w1.x; o[5] += hv * w1.y; o[6] += hv * w1.z; o[7] += hv * w1.w; }
        const v4u cg = *(const GAS v4u*)(base + (size_t)t * DIN + C_CG + c0);
        v4u ov; ov.x = pk2(o[0] * silu_f(bflo(cg.x)), o[1] * silu_f(bfhi(cg.x))); ov.y = pk2(o[2] * silu_f(bflo(cg.y)), o[3] * silu_f(bfhi(cg.y)));
        ov.z = pk2(o[4] * silu_f(bflo(cg.z)), o[5] * silu_f(bfhi(cg.z))); ov.w = pk2(o[6] * silu_f(bflo(cg.w)), o[7] * silu_f(bfhi(cg.w)));
        *(GAS v4u*)(F.ymix + (size_t)(b * SEQ + t) * DM + Y_C + c0) = ov;
        LDS_WAIT(); asm volatile("" ::: "memory");
    }
}

__device__ __forceinline__ void ln_phase(Frame& F, int layer, bool write_xb) {
    PHASE_IDS();
    const int gw = blockIdx.x * NWAVES + wave, NGW = F.G * NWAVES;
    const float* g = F.ln_g + layer * DM; const float* bb = F.ln_b + layer * DM;
    for (int row = gw; row < MROWS; row += NGW) {
        GAS f32x4* xr = (GAS f32x4*)(F.out + (size_t)row * DM) + lane;
        f32x4 v[8]; float s = 0.f;
#pragma unroll
        for (int j = 0; j < 8; ++j) { v[j] = xr[64 * j]; s += (v[j].x + v[j].y) + (v[j].z + v[j].w); }
        const float mean = wave_sum(s) * (1.f / DM); float s2 = 0.f;
#pragma unroll
        for (int j = 0; j < 8; ++j) { v[j] = v[j] - mean; s2 += (v[j].x * v[j].x + v[j].y * v[j].y) + (v[j].z * v[j].z + v[j].w * v[j].w); }
        const float rstd = rsqrtf(wave_sum(s2) * (1.f / DM) + LN_EPS);
#pragma unroll
        for (int j = 0; j < 8; ++j) { const int c = 4 * lane + 256 * j; const f32x4 gv = *(const GAS f32x4*)(g + c), bv = *(const GAS f32x4*)(bb + c);
            const f32x4 o = v[j] * rstd * gv + bv; xr[64 * j] = o;
            if (write_xb) { v2u w; w.x = pk2(o.x, o.y); w.y = pk2(o.z, o.w); *(GAS v2u*)(F.xb + (size_t)row * DM + c) = w; } }
    }
}


#define RLX_AGENT __ATOMIC_RELAXED, __HIP_MEMORY_SCOPE_AGENT
#define XB_TMO      128
#define XB_XCNT(j)  (256  + 64 * (j))
#define XB_XSUB(j)  (1280 + 64 * (j))
#define XB_XGEN(j)  (2304 + 64 * (j))
#define XB_TOP      3328
#define XB_TOPGEN   3392
#define XCD_BAR_WORDS 3456
#define XB_SPIN_CAP (1u << 18)

__device__ __forceinline__ unsigned xb_ld(unsigned* p)              { return __hip_atomic_load(p, __ATOMIC_RELAXED, __HIP_MEMORY_SCOPE_AGENT); }
__device__ __forceinline__ unsigned xb_add(unsigned* p, unsigned v) { return __hip_atomic_fetch_add(p, v, __ATOMIC_RELAXED, __HIP_MEMORY_SCOPE_AGENT); }
__device__ __forceinline__ unsigned xb_xcc_id() { return (unsigned)__builtin_amdgcn_s_getreg((3 << 11) | 20) & 0xFu; }
#define XB_SPIN(cond, bar) do { unsigned _sp = 0; while (cond) { __builtin_amdgcn_s_sleep(1); \
    if ((++_sp & 255u) == 0u) { if (xb_ld(&(bar)[XB_TMO])) break; if (_sp > XB_SPIN_CAP) { atomicAdd(&(bar)[XB_TMO], 1u); break; } } } } while (0)

struct XcdBarrier {
    unsigned* bar; unsigned x;
    volatile LAS unsigned* st;
};

__device__ __forceinline__ XcdBarrier xcd_barrier_post(unsigned* bar, volatile LAS unsigned* st, bool t0) {
    XcdBarrier b; b.bar = bar; b.x = xb_xcc_id(); b.st = st;
    if (t0) (void)xb_add(&bar[XB_XCNT(b.x)], 1u);
    return b;
}
__device__ __forceinline__ void xcd_barrier_complete(unsigned* bar, unsigned x, unsigned& nloc, unsigned& nx) {
    const unsigned G = gridDim.x * gridDim.y * gridDim.z;
    unsigned sum, cnt, mine, sp = 0u;
    for (;;) {
        sum = 0u; cnt = 0u; mine = 0u;
#pragma unroll
        for (unsigned j = 0; j < 16; ++j) { const unsigned c = xb_ld(&bar[XB_XCNT(j)]); sum += c; cnt += (c > 0u) ? 1u : 0u; mine = (j == x) ? c : mine; }
        if (sum == G) break;
        __builtin_amdgcn_s_sleep(1);
        if ((++sp & 255u) == 0u) { if (xb_ld(&bar[XB_TMO])) break; if (sp > XB_SPIN_CAP) { atomicAdd(&bar[XB_TMO], 1u); break; } }
    }
    nloc = mine > 0u ? mine : 1u; nx = cnt > 0u ? cnt : 1u;
}

__device__ __forceinline__ void xcd_barrier(const XcdBarrier& b, bool t0) {
    asm volatile("s_waitcnt vmcnt(0)" ::: "memory");
    __syncthreads();
    if (t0) {
        unsigned* bar = b.bar;
        __builtin_amdgcn_s_waitcnt(0);
        unsigned nloc = b.st[0], nx = b.st[1];
        if (nloc == 0u) { xcd_barrier_complete(bar, b.x, nloc, nx); b.st[0] = nloc; b.st[1] = nx; }
        const unsigned old = xb_add(&bar[XB_XSUB(b.x)], 1u);
        const unsigned gen = old / nloc;
        if (old + 1u == (gen + 1u) * nloc) {
            __builtin_amdgcn_fence(__ATOMIC_RELEASE, "agent");
            asm volatile("s_waitcnt vmcnt(0)" ::: "memory");
            const unsigned og = xb_add(&bar[XB_TOP], 1u);
            const unsigned tg = og / nx;
            if (og + 1u == (tg + 1u) * nx) xb_add(&bar[XB_TOPGEN], 1u);
            else XB_SPIN(xb_ld(&bar[XB_TOPGEN]) == tg, bar);
            __builtin_amdgcn_fence(__ATOMIC_ACQUIRE, "agent");
            xb_add(&bar[XB_XGEN(b.x)], 1u);
            asm volatile("s_waitcnt vmcnt(0)" ::: "memory");
        } else {
            XB_SPIN(xb_ld(&bar[XB_XGEN(b.x)]) == gen, bar);
            __builtin_amdgcn_fence(__ATOMIC_ACQUIRE, "agent");
            asm volatile("s_waitcnt vmcnt(0)" ::: "memory");
        }
    }
    __syncthreads();
}

typedef short bf16x8 __attribute__((ext_vector_type(8)));
typedef float f32x16 __attribute__((ext_vector_type(16)));
typedef short s16x4 __attribute__((ext_vector_type(4)));
typedef float f32x2 __attribute__((ext_vector_type(2)));
#define MFMA32(a, b, c) __builtin_amdgcn_mfma_f32_32x32x16_bf16((a), (b), (c), 0, 0, 0)
constexpr int AT_BUF = 8192;
constexpr int AT_WAVE = 2 * AT_BUF;
constexpr int AT_PAD = 32;
constexpr float AT_MASK = -3.0e38f, AT_MINIT = -1.0e30f;
constexpr float LOG2E = 1.4426950408889634f;
#define AT_WAITV(n) asm volatile("s_waitcnt vmcnt(" #n ")" ::: "memory")
#define AT_WAITL() asm volatile("s_waitcnt lgkmcnt(0)" ::: "memory")

__device__ __forceinline__ s16x4 ds_tr16(LAS const unsigned char* p) {
    typedef short v4i16_t __attribute__((ext_vector_type(4)));
    return __builtin_bit_cast(s16x4, __builtin_amdgcn_ds_read_tr16_b64_v4i16((LAS v4i16_t*)p));
}
__device__ __forceinline__ unsigned cvtpk(float lo, float hi) { typedef float f2 __attribute__((ext_vector_type(2))); typedef __bf16 b2 __attribute__((ext_vector_type(2))); f2 v = {lo, hi}; b2 b = __builtin_convertvector(v, b2); return __builtin_bit_cast(unsigned, b); }

struct RowMap { int p0, str, hi; };
struct LaneOff { unsigned k[4], v; };
__device__ __forceinline__ LaneOff lane_off(int str, int lane) {
    const int rl = lane >> 4, s = lane & 15; LaneOff o;
#pragma unroll
    for (int i = 0; i < 4; ++i) o.k[i] = (unsigned)(rl * str * DIN + ((s ^ (4 * i + rl)) * 8)) * 2u;
    o.v = (unsigned)(rl * str * DIN + ((s ^ (rl << 2)) * 8)) * 2u;
    return o;
}
__device__ __forceinline__ void glds16(const GAS char* sbase, unsigned voff, unsigned ldsaddr) {
    unsigned keep;
    asm volatile("s_nop 4\n\ts_mov_b32 %0, m0\n\ts_mov_b32 m0, %3\n\ts_nop 0\n\tglobal_load_lds_dwordx4 %1, %2\n\ts_mov_b32 m0, %0" : "=&s"(keep) : "v"(voff), "s"(sbase), "s"(ldsaddr) : "memory");
}
template <bool ISV> __device__ __forceinline__ void glds_tile(LAS unsigned char* buf, const bf16* base, int col, const RowMap rm, const LaneOff& lo) {
    const unsigned long long ub64 = (unsigned long long)(uintptr_t)(base + (size_t)rm.p0 * DIN + col);
    const GAS char* ub = (const GAS char*)(uintptr_t)(((unsigned long long)(unsigned)__builtin_amdgcn_readfirstlane((int)(ub64 >> 32)) << 32) | (unsigned)__builtin_amdgcn_readfirstlane((int)ub64));
    const unsigned la = (unsigned)__builtin_amdgcn_readfirstlane((int)(unsigned)(uintptr_t)buf);
#pragma unroll
    for (int i = 0; i < 8; ++i) { const unsigned uo = (unsigned)((4 * (i & 3) * rm.str + (i >> 2) * rm.hi) * DIN) * 2u;
        glds16(ub + uo, ISV ? lo.v : lo.k[i & 3], la + i * 1024); }
}
__device__ __forceinline__ bf16x8 kimg_frag(LAS const unsigned char* img, int c, int lane) {
    const int r = lane & 31;
    return *(LAS const bf16x8*)(img + r * 256 + (((2 * c + (lane >> 5)) ^ (r & 15)) << 4));
}

template <int NS> struct AttnState { f32x16 o[NS][4]; float m[NS], l[NS]; };

template <int NS>
__device__ __forceinline__ void attn_subtile(AttnState<NS>& S, const bf16x8 (&qf)[8], LAS unsigned char* kbuf, LAS unsigned char* vbuf, const bf16* base, int colK, int colV, const RowMap nrm, bool has_next,
                                             LAS const float* tab, int jlo, int jhi, float c1, int lane, const LaneOff& lo) {
    AT_WAITV(8);
    f32x16 p[NS];
#pragma unroll
    for (int s = 0; s < NS; ++s) {
        constexpr int NC = 8 / NS;
        bf16x8 kf[NC];
#pragma unroll
        for (int c = 0; c < NC; ++c) kf[c] = kimg_frag(kbuf, s * NC + c, lane);
        if (s == NS - 1) { AT_WAITL(); __builtin_amdgcn_sched_barrier(0); if (has_next) glds_tile<false>(kbuf, base, colK, nrm, lo); }
        f32x16 acc = {0.f, 0.f, 0.f, 0.f, 0.f, 0.f, 0.f, 0.f, 0.f, 0.f, 0.f, 0.f, 0.f, 0.f, 0.f, 0.f};
#pragma unroll
        for (int c = 0; c < NC; ++c) acc = MFMA32(kf[c], qf[s * NC + c], acc);
        p[s] = acc;
    }
    { LAS const float* tl = tab + jlo; LAS const float* th = tab + jhi;
#pragma unroll
      for (int r = 0; r < 16; ++r) { const float bias = (r < 8 ? tl : th)[(r & 3) + 8 * (r >> 2)];
#pragma unroll
          for (int s = 0; s < NS; ++s) p[s][r] = p[s][r] * c1 + bias; } }
    unsigned pb[NS][2][4];
#pragma unroll
    for (int s = 0; s < NS; ++s) {
        float mx = AT_MASK;
#pragma unroll
        for (int r = 0; r < 16; ++r) mx = fmaxf(mx, p[s][r]);
        mx = xor32_max(mx);
        const float mn = fmaxf(S.m[s], mx);
        if (__any(mn > S.m[s])) {
            const float al = __builtin_amdgcn_exp2f(S.m[s] - mn);
            S.l[s] *= al;
#pragma unroll
            for (int d = 0; d < 4; ++d)
#pragma unroll
                for (int r = 0; r < 16; ++r) S.o[s][d][r] *= al;
            S.m[s] = mn;
        }
        float ls = 0.f;
#pragma unroll
        for (int r = 0; r < 16; ++r) { p[s][r] = __builtin_amdgcn_exp2f(p[s][r] - mn); ls += p[s][r]; }
        S.l[s] += ls;
#pragma unroll
        for (int k = 0; k < 2; ++k)
#pragma unroll
            for (int j = 0; j < 4; ++j) pb[s][k][j] = cvtpk(p[s][8 * k + 2 * j], p[s][8 * k + 2 * j + 1]);
    }
    if (has_next) AT_WAITV(8); else AT_WAITV(0);
    { const int hi = lane >> 5, qq = (lane & 15) >> 2, pp = lane & 3, g1 = (lane >> 4) & 1;
      LAS const unsigned char* vrow = vbuf + (4 * hi + qq) * 256 + (2 * g1 + (pp >> 1)) * 16 + (pp & 1) * 8;
#pragma unroll
      for (int d = 0; d < 4; ++d) { LAS const unsigned char* vb = vrow + ((d ^ qq) << 6);
#pragma unroll
          for (int k = 0; k < 2; ++k) {
              const s16x4 lo = ds_tr16(vb + (16 * k) * 256), hh = ds_tr16(vb + (16 * k + 8) * 256);
              const bf16x8 vf = {lo[0], lo[1], lo[2], lo[3], hh[0], hh[1], hh[2], hh[3]};
#pragma unroll
              for (int s = 0; s < NS; ++s) { const v4u w = {pb[s][k][0], pb[s][k][1], pb[s][k][2], pb[s][k][3]}; S.o[s][d] = MFMA32(vf, __builtin_bit_cast(bf16x8, w), S.o[s][d]); } } } }
    AT_WAITL(); __builtin_amdgcn_sched_barrier(0);
    if (has_next) glds_tile<true>(vbuf, base, colV, nrm, lo);
}
template <int NS> __device__ __forceinline__ void attn_init(AttnState<NS>& S) {
#pragma unroll
    for (int s = 0; s < NS; ++s) { S.m[s] = AT_MINIT; S.l[s] = 0.f;
#pragma unroll
        for (int d = 0; d < 4; ++d) S.o[s][d] = (f32x16){0.f, 0.f, 0.f, 0.f, 0.f, 0.f, 0.f, 0.f, 0.f, 0.f, 0.f, 0.f, 0.f, 0.f, 0.f, 0.f}; }
}
__device__ __forceinline__ void load_qfrags(bf16x8 (&qf)[8], LAS unsigned char* kbuf, const bf16* base, int col, const RowMap rm, int lane, const LaneOff& lo) {
    glds_tile<false>(kbuf, base, col, rm, lo);
    AT_WAITV(0);
#pragma unroll
    for (int c = 0; c < 8; ++c) qf[c] = kimg_frag(kbuf, c, lane);
    AT_WAITL(); __builtin_amdgcn_sched_barrier(0);
}

constexpr int MX_STG = 0;
constexpr int MX_TABA = 8 * AT_WAVE;
constexpr int TABA_N = 2048 + 2 * AT_PAD + 1;
constexpr int MX_ITEM = 163840 - 64;
static_assert(MX_TABA + TABA_N * 4 <= MX_ITEM, "mixer A LDS map");

__device__ __forceinline__ void mixer_a_block(Frame& F, int layer, int b, int h, int qb, int wave, int lane) {
    LAS unsigned char* kbuf = F.lds + MX_STG + wave * AT_WAVE; LAS unsigned char* vbuf = kbuf + AT_BUF;
    LAS const float* tab = (LAS const float*)(F.lds + MX_TABA);
    const bf16* base = F.proj + (size_t)(b * SEQ) * DIN;
    const int q0 = qb * 256 + wave * 32, colK = C_AK + h * 128, colV = C_AV + h * 128;
    bf16x8 qf[8];
    const LaneOff lo = lane_off(1, lane);
    load_qfrags(qf, kbuf, base, C_AQ + h * 128, RowMap{q0, 1, 16}, lane, lo);
    AttnState<2> S; attn_init<2>(S);
    const int nsub = q0 / 32 + 1;
    const int hi = lane >> 5, ql = lane & 31;
    int jb = AT_PAD + 2047 - q0 - ql + 4 * hi;
    glds_tile<false>(kbuf, base, colK, RowMap{0, 1, 16}, lo); glds_tile<true>(vbuf, base, colV, RowMap{0, 1, 16}, lo);
#pragma unroll 1
    for (int u = 0; u < nsub; ++u, jb += 32)
        attn_subtile<2>(S, qf, kbuf, vbuf, base, colK, colV, RowMap{32 * (u + 1), 1, 16}, u + 1 < nsub, tab, jb, jb, 0.125f * LOG2E, lane, lo);
    const float lam = F.lamv[layer], li = lam_init_of(layer);
    const float l0 = xor32_sum(S.l[0]), l1 = xor32_sum(S.l[1]);
    const float i0 = 1.f / l0, i1 = lam / l1;
    float ss = 0.f;
#pragma unroll
    for (int d = 0; d < 4; ++d)
#pragma unroll
        for (int r = 0; r < 16; ++r) { const float v = S.o[0][d][r] * i0 - S.o[1][d][r] * i1; S.o[0][d][r] = v; ss += v * v; }
    ss = xor32_sum(ss);
    const float rn = rsqrtf(ss * (1.f / 128.f) + LN_EPS) * (1.f - li);
    const size_t row = (size_t)(b * SEQ + q0 + ql);
    const bf16* gp = F.proj + row * DIN + C_AG + h * 128 + 4 * hi;
    bf16* op = F.ymix + row * DM + Y_A + h * 128 + 4 * hi;
    const float* gn = F.head_gain + layer * 128 + 4 * hi;
#pragma unroll
    for (int d = 0; d < 4; ++d)
#pragma unroll
        for (int g = 0; g < 4; ++g) {
            const int dd = 32 * d + 8 * g;
            const v2u ag = *(const GAS v2u*)(gp + dd); const f32x4 gv = *(const GAS f32x4*)(gn + dd);
            v2u o; o.x = pk2(S.o[0][d][4 * g] * rn * gv.x * silu_f(bflo(ag.x)), S.o[0][d][4 * g + 1] * rn * gv.y * silu_f(bfhi(ag.x)));
            o.y = pk2(S.o[0][d][4 * g + 2] * rn * gv.z * silu_f(bflo(ag.y)), S.o[0][d][4 * g + 3] * rn * gv.w * silu_f(bfhi(ag.y)));
            *(GAS v2u*)(op + dd) = o;
        }
    AT_WAITV(0);
}
__device__ __forceinline__ void mixer_a_item(Frame& F, int layer, int item, int tid_, int wave_, int lane_) {
    int wave = wave_, lane = (int)__builtin_amdgcn_mbcnt_hi(~0u, __builtin_amdgcn_mbcnt_lo(~0u, 0u)); asm volatile("" : "+v"(lane)); asm volatile("" : "+s"(wave)); const int tid = wave * 64 + lane; (void)tid_; (void)lane_;
    const int pr = item & 3, bh = item >> 2, h = bh & 3, b = bh >> 2;
    LAS float* tab = (LAS float*)(F.lds + MX_TABA);
    for (int j = tid; j < TABA_N; j += NWAVES * 64) { const int rel = 2047 + AT_PAD - j; tab[j] = (rel >= 0 && rel <= 2047) ? F.biasA[h * 2048 + rel] * LOG2E : AT_MASK; }
    AT_WAITV(0);
    __syncthreads();
    mixer_a_block(F, layer, b, h, 7 - pr, wave, lane);
    mixer_a_block(F, layer, b, h, pr, wave, lane);
    __syncthreads();
}

constexpr int MX_TABB = 8 * AT_WAVE, TABB_N = 200;
static_assert(MX_TABB + 3 * TABB_N * 4 <= MX_ITEM, "mixer B LDS map");
constexpr size_t BST_ROW = 128 * 4 + 16, BST_BYTES = 256 * BST_ROW;

__device__ __forceinline__ void b_state_save(unsigned char* st, const AttnState<1>& S, int tau, int lane) {
    const int hi = lane >> 5;
    float* row = (float*)(st + (size_t)tau * BST_ROW) + 4 * hi;
#pragma unroll
    for (int d = 0; d < 4; ++d)
#pragma unroll
        for (int g = 0; g < 4; ++g) *(GAS f32x4*)(row + 32 * d + 8 * g) = (f32x4){S.o[0][d][4 * g], S.o[0][d][4 * g + 1], S.o[0][d][4 * g + 2], S.o[0][d][4 * g + 3]};
    const float lt = xor32_sum(S.l[0]);
    if (hi == 0) { f32x2 ml = {S.m[0], lt}; *(GAS f32x2*)((float*)(st + (size_t)tau * BST_ROW) + 128) = ml; }
}
__device__ __forceinline__ void b_state_load(const unsigned char* st, AttnState<1>& S, int tau, int lane) {
    const int hi = lane >> 5;
    const float* row = (const float*)(st + (size_t)tau * BST_ROW) + 4 * hi;
#pragma unroll
    for (int d = 0; d < 4; ++d)
#pragma unroll
        for (int g = 0; g < 4; ++g) { const f32x4 w = *(const GAS f32x4*)(row + 32 * d + 8 * g);
            S.o[0][d][4 * g] = w.x; S.o[0][d][4 * g + 1] = w.y; S.o[0][d][4 * g + 2] = w.z; S.o[0][d][4 * g + 3] = w.w; }
    const f32x2 ml = *(const GAS f32x2*)((const float*)(st + (size_t)tau * BST_ROW) + 128);
    S.m[0] = ml.x; S.l[0] = hi == 0 ? ml.y : 0.f;
}

__device__ __forceinline__ void mixer_b_item(Frame& F, int layer, int item, int tid_, int wave_, int lane_) {
    int wave = wave_, lane = (int)__builtin_amdgcn_mbcnt_hi(~0u, __builtin_amdgcn_mbcnt_lo(~0u, 0u)); asm volatile("" : "+v"(lane)); asm volatile("" : "+s"(wave)); const int tid = wave * 64 + lane; (void)tid_; (void)lane_;
    const int blk = item & 7, bh = item >> 3, h = bh & 7, b = bh >> 3, T0 = blk * 256;
    LAS float* tabs = (LAS float*)(F.lds + MX_TABB);
    for (int j = tid; j < 3 * TABB_N; j += NWAVES * 64) { const int p = j / TABB_N, jj = j - p * TABB_N, rel = 128 + AT_PAD - jj;
        tabs[j] = (rel >= 0 && rel <= 128) ? F.biasB[(p * 8 + h) * 132 + rel] * LOG2E : AT_MASK; }
    AT_WAITV(0);
    __syncthreads();
    LAS unsigned char* kbuf = F.lds + MX_STG + wave * AT_WAVE; LAS unsigned char* vbuf = kbuf + AT_BUF;
    unsigned char* st = F.bstate + (size_t)blockIdx.x * BST_BYTES;
    const bf16* base = F.proj + (size_t)(b * SEQ) * DIN;
    const int colQ = C_BQ + h * 128, colK = C_BK + h * 128, colV = C_BV + h * 128;
    const float c1 = 0.08838834764831845f * LOG2E;
    const int hi = lane >> 5, ql = lane & 31;
    AttnState<1> S; bf16x8 qf[8];
    { attn_init<1>(S);
      const LaneOff lo = lane_off(1, lane);
      load_qfrags(qf, kbuf, base, colQ, RowMap{T0 + 32 * wave, 1, 16}, lane, lo);
      const int k0 = T0 + 32 * wave - 128; const int u0 = k0 < 0 ? (-k0) >> 5 : 0;
      glds_tile<false>(kbuf, base, colK, RowMap{k0 + 32 * u0, 1, 16}, lo); glds_tile<true>(vbuf, base, colV, RowMap{k0 + 32 * u0, 1, 16}, lo);
#pragma unroll 1
      for (int u = u0; u < 5; ++u) { const int jb = AT_PAD - ql + 32 * u + 4 * hi;
          attn_subtile<1>(S, qf, kbuf, vbuf, base, colK, colV, RowMap{k0 + 32 * (u + 1), 1, 16}, u + 1 < 5, tabs, jb, jb, c1, lane, lo); }
      b_state_save(st, S, 32 * wave + ql, lane); }
    AT_WAITV(0); __syncthreads();
    { const int r = wave & 3, c = wave >> 2, tau = 128 * c + 4 * ql + r;
      b_state_load(st, S, tau, lane);
      AT_WAITV(0); asm volatile("" ::: "memory");
      const LaneOff lo = lane_off(4, lane);
      load_qfrags(qf, kbuf, base, colQ, RowMap{T0 + 128 * c + r, 4, 64}, lane, lo);
      const int l0 = T0 / 4 + 32 * c - 128; const int u0 = l0 < 0 ? (-l0) >> 5 : 0;
      glds_tile<false>(kbuf, base, colK, RowMap{4 * (l0 + 32 * u0) + r, 4, 64}, lo); glds_tile<true>(vbuf, base, colV, RowMap{4 * (l0 + 32 * u0) + r, 4, 64}, lo);
#pragma unroll 1
      for (int u = u0; u < 5; ++u) { const int jb = AT_PAD - ql + 32 * u + 4 * hi;
          attn_subtile<1>(S, qf, kbuf, vbuf, base, colK, colV, RowMap{4 * (l0 + 32 * (u + 1)) + r, 4, 64}, u + 1 < 5, tabs + TABB_N, jb, jb, c1, lane, lo); }
      b_state_save(st, S, tau, lane); }
    AT_WAITV(0); __syncthreads();
    { const int tau = 16 * (ql & 15) + 2 * wave + (ql >> 4);
      b_state_load(st, S, tau, lane);
      AT_WAITV(0); asm volatile("" ::: "memory");
      const LaneOff lo = lane_off(16, lane);
      load_qfrags(qf, kbuf, base, colQ, RowMap{T0 + 2 * wave, 16, 1}, lane, lo);
      const int x0 = T0 / 16 - 128; const int v0 = x0 < 0 ? (-x0) >> 4 : 0;
      glds_tile<false>(kbuf, base, colK, RowMap{16 * (x0 + 16 * v0) + 2 * wave, 16, 1}, lo); glds_tile<true>(vbuf, base, colV, RowMap{16 * (x0 + 16 * v0) + 2 * wave, 16, 1}, lo);
#pragma unroll 1
      for (int v = v0; v < 9; ++v) { const int jv = AT_PAD + 16 * v - ql + 4 * hi;
          attn_subtile<1>(S, qf, kbuf, vbuf, base, colK, colV, RowMap{16 * (x0 + 16 * (v + 1)) + 2 * wave, 16, 1}, v + 1 < 9, tabs + 2 * TABB_N, (ql < 16) ? jv : 0, (ql < 16) ? 0 : jv, c1, lane, lo); }
      const float lt = xor32_sum(S.l[0]), il = 1.f / lt;
      const size_t row = (size_t)(b * SEQ + T0 + tau);
      const bf16* gp = F.proj + row * DIN + C_BG + h * 128 + 4 * hi;
      bf16* op = F.ymix + row * DM + Y_B + h * 128 + 4 * hi;
#pragma unroll
      for (int d = 0; d < 4; ++d)
#pragma unroll
          for (int g = 0; g < 4; ++g) { const int dd = 32 * d + 8 * g; const v2u bg = *(const GAS v2u*)(gp + dd);
              v2u o; o.x = pk2(S.o[0][d][4 * g] * il * silu_f(bflo(bg.x)), S.o[0][d][4 * g + 1] * il * silu_f(bfhi(bg.x)));
              o.y = pk2(S.o[0][d][4 * g + 2] * il * silu_f(bflo(bg.y)), S.o[0][d][4 * g + 3] * il * silu_f(bfhi(bg.y)));
              *(GAS v2u*)(op + dd) = o; } }
    AT_WAITV(0); __syncthreads();
}

constexpr int MC_AIMG = 0, MC_ACH = 64 * 16 + 16;
constexpr int MC_PART = 64 * MC_ACH;
constexpr int MC_STAT = MC_PART + 2 * 64 * 64 * 4;
static_assert(MC_STAT + 512 <= MX_ITEM, "mixer C LDS map");

template <int I0> __device__ __forceinline__ void conv_group(f32x2 (&acc)[32], const f32x2 (&w)[CONVW], const bf16* base, int tb, int c0) {
    f32x2 g[8];
#pragma unroll
    for (int ii = 0; ii < 8; ++ii) { const int i = I0 + ii; if (i < 32 + CONVW - 1) {
        const int tk = tb + i, tc = tk < 0 ? 0 : tk;
        const unsigned u = *(const GAS unsigned*)(base + (size_t)tc * DIN + C_CU + c0), gl = *(const GAS unsigned*)(base + (size_t)tc * DIN + C_CGLU + c0);
        g[ii].x = bflo(u) * sigmoid_f(bflo(gl)); g[ii].y = bfhi(u) * sigmoid_f(bfhi(gl));
        if (tk < 0) { g[ii].x = 0.f; g[ii].y = 0.f; } } }
#pragma unroll
    for (int ii = 0; ii < 8; ++ii)
#pragma unroll
        for (int j = 0; j < CONVW; ++j) { const int i = I0 + ii, o = i - j; if (i < 32 + CONVW - 1 && o >= 0 && o < 32) acc[o] = w[j] * g[ii] + acc[o]; }
    asm volatile("" ::: "memory");
}

__device__ __forceinline__ void mixer_c_item(Frame& F, int layer, int item, int tid_, int wave_, int lane_) {
    int wave = wave_, lane = (int)__builtin_amdgcn_mbcnt_hi(~0u, __builtin_amdgcn_mbcnt_lo(~0u, 0u)); asm volatile("" : "+v"(lane)); asm volatile("" : "+s"(wave)); const int tid = wave * 64 + lane; (void)tid_; (void)lane_;
    const int b = item >> 5, t0 = (item & 31) * 64;
    const bf16* base = F.proj + (size_t)(b * SEQ) * DIN;
    const int cp = tid & 255, th = tid >> 8, c0 = 2 * cp;
    f32x2 acc[32];
    {
        f32x2 w[CONVW];
        const float* dw = F.conv_dw + (size_t)layer * CONVW * DC + c0;
#pragma unroll
        for (int j = 0; j < CONVW; ++j) w[j] = *(const GAS f32x2*)(dw + j * DC);
        const f32x2 cb = *(const GAS f32x2*)(F.conv_b + layer * DC + c0);
#pragma unroll
        for (int o = 0; o < 32; ++o) acc[o] = cb;
        const int tb = t0 + 32 * th - (CONVW - 1);
        conv_group<0>(acc, w, base, tb, c0); conv_group<8>(acc, w, base, tb, c0); conv_group<16>(acc, w, base, tb, c0); conv_group<24>(acc, w, base, tb, c0);
        conv_group<32>(acc, w, base, tb, c0); conv_group<40>(acc, w, base, tb, c0); conv_group<48>(acc, w, base, tb, c0); conv_group<56>(acc, w, base, tb, c0);
    }
    { LAS float* part = (LAS float*)(F.lds + MC_PART);
#pragma unroll
      for (int o = 0; o < 32; ++o) { float s1 = acc[o].x + acc[o].y, s2 = acc[o].x * acc[o].x + acc[o].y * acc[o].y;
          s1 = quad_sum(s1); s2 = quad_sum(s2);
          if ((lane & 3) == 0) { part[(32 * th + o) * 64 + (cp >> 2)] = s1; part[4096 + (32 * th + o) * 64 + (cp >> 2)] = s2; } } }
    __syncthreads();
    { LAS const float* part = (LAS const float*)(F.lds + MC_PART); LAS float* stat = (LAS float*)(F.lds + MC_STAT);
      const int tok = tid >> 3, k = tid & 7;
      const f32x4 a0 = *(LAS const f32x4*)(part + tok * 64 + 8 * k), a1 = *(LAS const f32x4*)(part + tok * 64 + 8 * k + 4);
      const f32x4 b0 = *(LAS const f32x4*)(part + 4096 + tok * 64 + 8 * k), b1 = *(LAS const f32x4*)(part + 4096 + tok * 64 + 8 * k + 4);
      float s1 = (a0.x + a0.y) + (a0.z + a0.w) + (a1.x + a1.y) + (a1.z + a1.w), s2 = (b0.x + b0.y) + (b0.z + b0.w) + (b1.x + b1.y) + (b1.z + b1.w);
      s1 = oct_sum(s1); s2 = oct_sum(s2);
      const float mean = s1 * (1.f / DC), var = fmaxf(s2 * (1.f / DC) - mean * mean, 0.f);
      if (k == 0) { stat[2 * tok] = mean; stat[2 * tok + 1] = rsqrtf(var + LN_EPS); } }
    __syncthreads();
    { LAS const f32x2* stat = (LAS const f32x2*)(F.lds + MC_STAT);
      const f32x2 lg = *(const GAS f32x2*)(F.conv_ln_g + layer * DC + c0), lb = *(const GAS f32x2*)(F.conv_ln_b + layer * DC + c0);
      LAS unsigned char* ap = F.lds + MC_AIMG + (cp >> 2) * MC_ACH + (32 * th) * 16 + (cp & 3) * 4;
#pragma unroll
      for (int o = 0; o < 32; ++o) { const f32x2 st = stat[32 * th + o];
          const float h0 = (acc[o].x - st.x) * st.y * lg.x + lb.x, h1 = (acc[o].y - st.x) * st.y * lg.y + lb.y;
          *(LAS unsigned*)(ap + o * 16) = cvtpk(silu_f(h0), silu_f(h1)); } }
    __syncthreads();
    f32x16 pa[2][2];
#pragma unroll
    for (int nt = 0; nt < 2; ++nt)
#pragma unroll
        for (int tt = 0; tt < 2; ++tt) pa[nt][tt] = (f32x16){0.f, 0.f, 0.f, 0.f, 0.f, 0.f, 0.f, 0.f, 0.f, 0.f, 0.f, 0.f, 0.f, 0.f, 0.f, 0.f};
    { const int hi = lane >> 5, ql = lane & 31;
      const bf16* wp = F.wpw_t + (size_t)layer * DC * DC + (size_t)(64 * wave + ql) * DC + 8 * hi;
      LAS const unsigned char* ab = F.lds + MC_AIMG + hi * MC_ACH + ql * 16;
#pragma unroll 4
      for (int c = 0; c < 32; ++c) {
          const bf16x8 w0 = *(const GAS bf16x8*)(wp + 16 * c), w1 = *(const GAS bf16x8*)(wp + 32 * DC + 16 * c);
          const bf16x8 x0 = *(LAS const bf16x8*)(ab + c * 2 * MC_ACH), x1 = *(LAS const bf16x8*)(ab + c * 2 * MC_ACH + 512);
          pa[0][0] = MFMA32(w0, x0, pa[0][0]); pa[0][1] = MFMA32(w0, x1, pa[0][1]); pa[1][0] = MFMA32(w1, x0, pa[1][0]); pa[1][1] = MFMA32(w1, x1, pa[1][1]); }
#pragma unroll
      for (int tt = 0; tt < 2; ++tt) { const size_t row = (size_t)(b * SEQ + t0 + 32 * tt + ql);
          const bf16* gp = F.proj + row * DIN + C_CG + 64 * wave + 4 * hi; bf16* op = F.ymix + row * DM + Y_C + 64 * wave + 4 * hi;
#pragma unroll
          for (int nt = 0; nt < 2; ++nt)
#pragma unroll
              for (int g = 0; g < 4; ++g) { const int nn = 32 * nt + 8 * g; const v2u cg = *(const GAS v2u*)(gp + nn);
                  v2u o; o.x = pk2(pa[nt][tt][4 * g] * silu_f(bflo(cg.x)), pa[nt][tt][4 * g + 1] * silu_f(bfhi(cg.x)));
                  o.y = pk2(pa[nt][tt][4 * g + 2] * silu_f(bflo(cg.y)), pa[nt][tt][4 * g + 3] * silu_f(bfhi(cg.y)));
                  *(GAS v2u*)(op + nn) = o; } } }
    __syncthreads();
}
struct Args { const float* in[13]; float* out; unsigned char* ws; int ph_lo, ph_hi; };
constexpr int N_PHASES = 1 + 4 * DEPTH;
constexpr int CW_BAR = 4096;
static_assert((CW_BAR + XCD_BAR_WORDS) * 4 <= (int)CTL_ZERO_BYTES, "control words inside the memset region");
#ifndef REP_PRO
#define REP_PRO 1
#endif
#ifndef REP_G1
#define REP_G1 1
#endif
#ifndef REP_MIX
#define REP_MIX 1
#endif
#ifndef REP_G2
#define REP_G2 1
#endif
#ifndef REP_LN
#define REP_LN 1
#endif
#ifndef MK_ONE_LAUNCH
#define MK_ONE_LAUNCH 1
#endif

constexpr int N_ITEMS_A = 128, N_ITEMS_B = 512, N_ITEMS_C = 256;
__device__ __forceinline__ void mixer_phase(Frame& F, int layer, int rep) {
    PHASE_IDS();
    volatile LAS unsigned* itemw = (volatile LAS unsigned*)(F.lds + MX_ITEM);
    unsigned* ctr = F.ctl + 64 * (layer + 2 * rep);
    for (;;) {
        if (tid == 0) *itemw = __hip_atomic_fetch_add(ctr, 1u, __ATOMIC_RELAXED, __HIP_MEMORY_SCOPE_AGENT);
        __syncthreads();
        const int item = __builtin_amdgcn_readfirstlane((int)*itemw);
        __syncthreads();
        if (item >= N_ITEMS_A + N_ITEMS_B + N_ITEMS_C) break;
        if (item < N_ITEMS_A) mixer_a_item(F, layer, item, tid, wave, lane);
        else if (item < N_ITEMS_A + N_ITEMS_B) mixer_b_item(F, layer, item - N_ITEMS_A, tid, wave, lane);
        else mixer_c_item(F, layer, item - N_ITEMS_A - N_ITEMS_B, tid, wave, lane);
    }
    __syncthreads();
}

__global__ void __launch_bounds__(NWAVES * 64, 2) hymba_fwd(Args args) {
    extern __shared__ __attribute__((aligned(16))) unsigned char lds[];
    Frame F;
    F.lds = (LAS unsigned char*)lds;
    F.G = gridDim.x; F.wave = __builtin_amdgcn_readfirstlane(threadIdx.x >> 6);
    unsigned char* ws = args.ws;
    F.x = args.in[0]; F.w_in = args.in[1]; F.diff_lambda = args.in[2]; F.head_gain = args.in[3]; F.conv_dw = args.in[4]; F.conv_b = args.in[5];
    F.conv_ln_g = args.in[6]; F.conv_ln_b = args.in[7]; F.conv_pw = args.in[8]; F.w_out = args.in[9]; F.ln_g = args.in[10]; F.ln_b = args.in[11]; F.rel_bias = args.in[12];
    F.out = args.out;
    F.win_t = (bf16*)(ws + WS_WIN); F.wout_t = (bf16*)(ws + WS_WOUT); F.wpw_t = (bf16*)(ws + WS_WPW); F.xb = (bf16*)(ws + WS_XB); F.ymix = (bf16*)(ws + WS_Y); F.proj = (bf16*)(ws + WS_PROJ);
    F.biasA = (float*)(ws + WS_TAB + TAB_BIASA); F.biasB = (float*)(ws + WS_TAB + TAB_BIASB); F.lamv = (float*)(ws + WS_TAB + TAB_LAM); F.ctl = (unsigned*)(ws + WS_CTL); F.bstate = ws + WS_BST;
    const int lo = args.ph_lo, hi = args.ph_hi;
#define IN(k) (lo <= (k) && (k) < hi)
#if MK_ONE_LAUNCH
    const bool t0 = (F.wave == 0) && (__builtin_amdgcn_mbcnt_hi(~0u, __builtin_amdgcn_mbcnt_lo(~0u, 0u)) == 0u);
    { volatile LAS unsigned* stw = (volatile LAS unsigned*)(F.lds + MX_ITEM + 16); if (t0) { stw[0] = 0u; stw[1] = 0u; } }
    __syncthreads();
    const XcdBarrier bar = xcd_barrier_post(F.ctl + CW_BAR, (volatile LAS unsigned*)(F.lds + MX_ITEM + 16), t0);
#define GRID_BAR() xcd_barrier(bar, (F.wave == 0) && (__builtin_amdgcn_mbcnt_hi(~0u, __builtin_amdgcn_mbcnt_lo(~0u, 0u)) == 0u))
#else
#define GRID_BAR() do {} while (0)
#endif
    if (IN(0)) { for (int rep = 0; rep < REP_PRO; ++rep) p0_prologue(F); if (IN(1)) GRID_BAR(); }
#define LAYER_ID 0
    { constexpr int layer = LAYER_ID; const int p = 1 + 4 * layer;
        if (IN(p)) {
            pg8::Gemm g{F.xb, F.win_t + (size_t)layer * DIN * DM, MROWS, DIN, DM}; pg8::StaticOrder S; S.init(MROWS, DIN, F.G, (int)blockIdx.x);
            pg8::EpiBf16<0> E{F.proj, DIN, nullptr, 0, 0, 1.f};
            for (int rep = 0; rep < REP_G1; ++rep) pg8::gemm_phase<pg8::EpiBf16<0>, pg8::StaticOrder, true, true>(F.lds, g, S, E, F.wave);
            if (IN(p + 1)) GRID_BAR();
        }
        if (IN(p + 1)) {
            for (int rep = 0; rep < REP_MIX; ++rep) mixer_phase(F, layer, rep);
            if (IN(p + 2)) GRID_BAR();
        }
        if (IN(p + 2)) {
            pg8::Gemm g{F.ymix, F.wout_t + (size_t)layer * DM * DM, MROWS, DM, DM}; pg8::StaticOrder S; S.init(MROWS, DM, F.G, (int)blockIdx.x);
            EpiResid E{layer == 0 ? F.x : F.out, F.out, DM, ALPHA};
            for (int rep = 0; rep < REP_G2; ++rep) pg8::gemm_phase<EpiResid, pg8::StaticOrder, true, true>(F.lds, g, S, E, F.wave);
            if (IN(p + 3)) GRID_BAR();
        }
        if (IN(p + 3)) {
            for (int rep = 0; rep < REP_LN; ++rep) ln_phase(F, layer, layer + 1 < DEPTH);
            if (IN(p + 4)) GRID_BAR();
        }
    }
#undef LAYER_ID
#define LAYER_ID 1
    { constexpr int layer = LAYER_ID; const int p = 1 + 4 * layer;
        if (IN(p)) {
            pg8::Gemm g{F.xb, F.win_t + (size_t)layer * DIN * DM, MROWS, DIN, DM}; pg8::StaticOrder S; S.init(MROWS, DIN, F.G, (int)blockIdx.x);
            pg8::EpiBf16<0> E{F.proj, DIN, nullptr, 0, 0, 1.f};
            for (int rep = 0; rep < REP_G1; ++rep) pg8::gemm_phase<pg8::EpiBf16<0>, pg8::StaticOrder, true, true>(F.lds, g, S, E, F.wave);
            if (IN(p + 1)) GRID_BAR();
        }
        if (IN(p + 1)) {
            for (int rep = 0; rep < REP_MIX; ++rep) mixer_phase(F, layer, rep);
            if (IN(p + 2)) GRID_BAR();
        }
        if (IN(p + 2)) {
            pg8::Gemm g{F.ymix, F.wout_t + (size_t)layer * DM * DM, MROWS, DM, DM}; pg8::StaticOrder S; S.init(MROWS, DM, F.G, (int)blockIdx.x);
            EpiResid E{layer == 0 ? F.x : F.out, F.out, DM, ALPHA};
            for (int rep = 0; rep < REP_G2; ++rep) pg8::gemm_phase<EpiResid, pg8::StaticOrder, true, true>(F.lds, g, S, E, F.wave);
            if (IN(p + 3)) GRID_BAR();
        }
        if (IN(p + 3)) {
            for (int rep = 0; rep < REP_LN; ++rep) ln_phase(F, layer, layer + 1 < DEPTH);
            if (IN(p + 4)) GRID_BAR();
        }
    }
#undef LAYER_ID
#undef IN
}

extern "C" void kernel_launch(void* const* d_in, const int* in_sizes, int n_in, void* d_out, int out_size, void* d_ws, size_t ws_size, hipStream_t stream) {
    static int grid = 0;
    if (grid == 0) {
        if (n_in != 13 || in_sizes[0] != MROWS * DM || out_size != MROWS * DM || ws_size < WS_END) { fprintf(stderr, "kernel_launch: unexpected shapes (n_in %d, in0 %d, out %d, ws %zu)\n", n_in, n_in > 0 ? in_sizes[0] : -1, out_size, ws_size); grid = -1; return; }
        int dev = 0, cus = 0, per_cu = 0;
        if (hipGetDevice(&dev) != hipSuccess || hipDeviceGetAttribute(&cus, hipDeviceAttributeMultiprocessorCount, dev) != hipSuccess) { grid = -1; return; }
        if (hipFuncSetAttribute((const void*)hymba_fwd, hipFuncAttributeMaxDynamicSharedMemorySize, LDS_BYTES) != hipSuccess) { fprintf(stderr, "kernel_launch: hipFuncSetAttribute failed\n"); grid = -1; return; }
        if (hipOccupancyMaxActiveBlocksPerMultiprocessor(&per_cu, (const void*)hymba_fwd, NWAVES * 64, LDS_BYTES) != hipSuccess || per_cu < 1) { fprintf(stderr, "kernel_launch: occupancy query says %d\n", per_cu); per_cu = 1; }
        (void)hipGetLastError();
        grid = cus;
    }
    if (grid < 0) return;
    if (hipMemsetAsync((char*)d_ws + WS_CTL, 0, CTL_ZERO_BYTES, stream) != hipSuccess) { fprintf(stderr, "kernel_launch: memset failed\n"); return; }
    Args a{};
    for (int i = 0; i < 13; ++i) a.in[i] = (const float*)d_in[i];
    a.out = (float*)d_out; a.ws = (unsigned char*)d_ws;
#if MK_ONE_LAUNCH
    a.ph_lo = 0; a.ph_hi = N_PHASES;
    hipLaunchKernelGGL(hymba_fwd, dim3(grid), dim3(NWAVES * 64), LDS_BYTES, stream, a);
    const hipError_t e = hipPeekAtLastError();
    if (e != hipSuccess) fprintf(stderr, "kernel_launch: launch failed: %s (grid %d)\n", hipGetErrorString(e), grid);
#else
    for (int ph = 0; ph < N_PHASES; ++ph) {
        a.ph_lo = ph; a.ph_hi = ph + 1;
        hipLaunchKernelGGL(hymba_fwd, dim3(grid), dim3(NWAVES * 64), LDS_BYTES, stream, a);
        const hipError_t le = hipPeekAtLastError();
        if (le != hipSuccess) { fprintf(stderr, "kernel_launch: launch %d failed: %s\n", ph, hipGetErrorName(le)); break; }
    }
#endif
}
```

```cpp
#include <hip/hip_runtime.h>
#include <hip/hip_cooperative_groups.h>
#include <cstdio>
#include <cstdint>
namespace pg8 {
#define PG8_LAS __attribute__((address_space(3)))
typedef unsigned short bf16_t;
typedef short bf16x8 __attribute__((ext_vector_type(8)));
typedef float f32x4 __attribute__((ext_vector_type(4)));
typedef unsigned u32x4 __attribute__((ext_vector_type(4)));
constexpr int BM = 256, BK = 64, HALF = 128, HTB = HALF * BK * 2  , STAGE_BYTES = 8 * HTB, NXCD = 8, WGM = 8;

__host__ __device__ __forceinline__ int lds_byte(int r, int c) { const int st = (r >> 4) * 2 + (c >> 5), rr = r & 15, cc = c & 31, ob = rr * 64 + cc * 2; return st * 1024 + (ob ^ (((ob >> 9) & 1) << 5)); }
__host__ __device__ __forceinline__ void stage_rc(int b, int& R, int& C) { const int st = b / 1024, sb = b % 1024, swz = sb ^ (((sb >> 9) & 1) << 5); R = (st >> 1) * 16 + swz / 64; C = (st & 1) * 32 + (swz % 64) / 2; }
__host__ __device__ __forceinline__ int perm32(int rho) { const int n = rho >> 4, i = rho & 15; return 8 * (i >> 2) + 4 * n + (i & 3); }

struct Unit { int pm, pn; };
struct Gemm { const bf16_t* A; const bf16_t* Bt; int M, N, K; };

struct StaticOrder {
    int nM, nN, nwg, G, c;
    __host__ __device__ void init(int M, int N, int G_, int c_) { nM = M / BM; nN = N / BM; nwg = nM * nN; G = G_; c = c_; }
    __host__ __device__ bool next(int i, Unit& u) const {
        const long L = (long)i * G + c; if (L >= nwg) return false;
        int wgid = (int)L; { const int q = nwg / NXCD, r = nwg % NXCD, xcd = wgid % NXCD, off = wgid / NXCD; wgid = (xcd < r ? xcd * (q + 1) : r * (q + 1) + (xcd - r) * q) + off; }
        const int nig = WGM * nN, gid = wgid / nig, fm = gid * WGM, gsz = (nM - fm) < WGM ? (nM - fm) : WGM;
        u.pm = fm + ((wgid % nig) % gsz); u.pn = (wgid % nig) / gsz; return true;
    }
    __device__ __forceinline__ void a_ready(const Unit&) const {}
    __device__ __forceinline__ void done(const Unit&) const {}
};

__device__ __forceinline__ unsigned cvt_pk_bf16(float lo, float hi) { unsigned r; asm volatile("v_cvt_pk_bf16_f32 %0, %1, %2" : "=v"(r) : "v"(lo), "v"(hi)); return r; }
typedef float f32x2 __attribute__((ext_vector_type(2)));
__device__ __forceinline__ f32x2 gelu_pk(f32x2 v) {
    const f32x2 av = __builtin_elementwise_abs(v), d = av * 0.2316418882f + 1.0f;
    f32x2 t; t.x = __builtin_amdgcn_rcpf(d.x); t.y = __builtin_amdgcn_rcpf(d.y);
    f32x2 q = t * 0.5307027145f + (-0.7265760135f); q = q * t + 0.7107068705f; q = q * t + (-0.142248368f); q = q * t + 0.127414796f; q = q * t;
    const f32x2 s = (v * v) * (-0.72134752044f);
    f32x2 e; e.x = __builtin_amdgcn_exp2f(s.x); e.y = __builtin_amdgcn_exp2f(s.y);
    const f32x2 m = v * (q * e), r = v - m;
    f32x2 o; o.x = v.x < 0.f ? m.x : r.x; o.y = v.y < 0.f ? m.y : r.y; return o;
}

template <int ACT  > struct EpiBf16 {
    static constexpr bool PERM = true, AFTER_DRAIN = false; static_assert(ACT == 0 || ACT == 1, "EpiBf16: ACT is 0 (none) or 1 (gelu_pk)");
    bf16_t* O; int ldc; const float* bias; int split_cols; size_t split_stride; float scale0;
    __device__ __forceinline__ void operator()(const f32x4 (&acc)[2][2][4][2], const Unit& u, int wr, int wc, int fr, int fq) const {
        const int row0 = u.pm * BM + wr * 64 + fr; int colt = u.pn * BM; bf16_t* base = O;
        float sc = 1.f; if (split_cols) { const int t = colt / split_cols; base += (size_t)t * split_stride; colt -= t * split_cols; if (t == 0) sc = scale0; }
        const int col0 = colt + wc * 32 + 8 * fq, bcol0 = u.pn * BM + wc * 32 + 8 * fq;
        f32x4 bv[2][2];
#pragma unroll
        for (int bj = 0; bj < 2; ++bj)
#pragma unroll
            for (int n = 0; n < 2; ++n) bv[bj][n] = bias ? *(const f32x4*)(bias + bcol0 + bj * HALF + 4 * n) : (f32x4){0.f, 0.f, 0.f, 0.f};
#pragma unroll
        for (int ai = 0; ai < 2; ++ai)
#pragma unroll
            for (int m = 0; m < 4; ++m) { bf16_t* rowp = base + (size_t)(row0 + ai * HALF + m * 16) * ldc + col0;
#pragma unroll
                for (int bj = 0; bj < 2; ++bj) { f32x4 v0 = acc[ai][bj][m][0] + bv[bj][0], v1 = acc[ai][bj][m][1] + bv[bj][1];
                    if (ACT == 1) { f32x2 a = gelu_pk((f32x2){v0[0], v0[1]}), b = gelu_pk((f32x2){v0[2], v0[3]}), c = gelu_pk((f32x2){v1[0], v1[1]}), d = gelu_pk((f32x2){v1[2], v1[3]});
                        v0 = (f32x4){a.x, a.y, b.x, b.y}; v1 = (f32x4){c.x, c.y, d.x, d.y}; }
                    v0 = v0 * sc; v1 = v1 * sc; u32x4 w; w.x = cvt_pk_bf16(v0[0], v0[1]); w.y = cvt_pk_bf16(v0[2], v0[3]); w.z = cvt_pk_bf16(v1[0], v1[1]); w.w = cvt_pk_bf16(v1[2], v1[3]);
                    *(u32x4*)(rowp + bj * HALF) = w; } }
    }
};

template <class Epi, class Sched, bool ALIGN_EPI = false, bool SP2 = false>
__device__ __forceinline__ void gemm_phase(PG8_LAS unsigned char* lds, const Gemm g, const Sched& S, const Epi& E, int wave_in) {
    int tid_; { unsigned l_; asm volatile("v_mbcnt_lo_u32_b32 %0, -1, 0\n\tv_mbcnt_hi_u32_b32 %0, -1, %0" : "=v"(l_)); tid_ = wave_in * 64 + (int)l_; }
    const int tid = tid_, wid = __builtin_amdgcn_readfirstlane(tid >> 6), lane = tid & 63, wr = wid >> 2, wc = wid & 3, fr = lane & 15, fq = lane >> 4;
    const int K = g.K, nt = K / BK;
    unsigned voffA[2], voffB[2];
#pragma unroll
    for (int i = 0; i < 2; ++i) { int R, C; stage_rc(tid * 16 + i * 8192, R, C); const int Rb = Epi::PERM ? ((R & ~31) + perm32(R & 31)) : R;
        voffA[i] = (unsigned)(R * K + C) * 2u; voffB[i] = (unsigned)(Rb * K + C) * 2u; }
    const size_t kstep = (size_t)(BK * 2);
    const size_t hstep = (size_t)HALF * K * 2;
    const size_t tstep = 2 * hstep;
    const unsigned ldsw = (unsigned)wid * 1024u;
    const int aoff = lds_byte(wr * 64 + fr, fq * 8), boff = lds_byte(wc * 32 + fr, fq * 8);
#define PG8_SA(b, h) (((b) * 2 + (h)) * HTB)
#define PG8_SB(b, h) ((4 + (b) * 2 + (h)) * HTB)
#define PG8_STAGE(bufoff, gbase, voff) do { _Pragma("unroll") for (int _i = 0; _i < 2; ++_i) \
        __builtin_amdgcn_global_load_lds((const unsigned*)((const char*)(gbase) + (voff)[_i]), (PG8_LAS unsigned*)(lds + (bufoff) + ldsw + _i * 8192), 16, 0, 0); } while (0)
#define PG8_LDA(dst, b, h) do { _Pragma("unroll") for (int m = 0; m < 4; ++m) _Pragma("unroll") for (int k = 0; k < 2; ++k) dst[m][k] = *(const PG8_LAS bf16x8*)(lds + PG8_SA(b, h) + aoff + m * 2048 + k * 1024); } while (0)
#define PG8_LDB(dst, b, h) do { _Pragma("unroll") for (int n = 0; n < 2; ++n) _Pragma("unroll") for (int k = 0; k < 2; ++k) dst[n][k] = *(const PG8_LAS bf16x8*)(lds + PG8_SB(b, h) + boff + n * 2048 + k * 1024); } while (0)
#define PG8_MMA(ai, bj, At, Bt) do { __builtin_amdgcn_s_setprio(1); _Pragma("unroll") for (int m = 0; m < 4; ++m) _Pragma("unroll") for (int n = 0; n < 2; ++n) _Pragma("unroll") for (int k = 0; k < 2; ++k) \
        acc[ai][bj][m][n] = __builtin_amdgcn_mfma_f32_16x16x32_bf16(Bt[n][k], At[m][k], acc[ai][bj][m][n], 0, 0, 0); __builtin_amdgcn_s_setprio(0); } while (0)
#define PG8_WAIT_V(n) asm volatile("s_waitcnt vmcnt(" #n ")" ::: "memory")
#define PG8_WAIT_L(n) asm volatile("s_waitcnt lgkmcnt(" #n ")" ::: "memory")
#define PG8_BAR __builtin_amdgcn_s_barrier()
#define PG8_SCHED __builtin_amdgcn_sched_barrier(0)
    Unit cur, nxt; int ui = 0;
    if (!S.next(0, cur)) return;
    f32x4 acc[2][2][4][2];
#pragma unroll
    for (int a = 0; a < 2; ++a)
#pragma unroll
        for (int b = 0; b < 2; ++b)
#pragma unroll
            for (int m = 0; m < 4; ++m)
#pragma unroll
                for (int n = 0; n < 2; ++n) acc[a][b][m][n] = (f32x4){0.f, 0.f, 0.f, 0.f};
    bf16x8 At[4][2], B0[2][2], B1[2][2];
    const char* cA = (const char*)g.A + (size_t)cur.pm * tstep; const char* cB = (const char*)g.Bt + (size_t)cur.pn * tstep;
    S.a_ready(cur);
    if constexpr (SP2) {
        PG8_STAGE(PG8_SB(0, 0), cB, voffB); PG8_STAGE(PG8_SB(0, 1), cB + hstep, voffB); PG8_STAGE(PG8_SA(0, 0), cA, voffA); PG8_STAGE(PG8_SA(0, 1), cA + hstep, voffA);
        if (wr == 1) PG8_BAR;
        PG8_WAIT_V(2); PG8_BAR;
        PG8_STAGE(PG8_SB(1, 0), cB + kstep, voffB); PG8_STAGE(PG8_SA(1, 0), cA + kstep, voffA); PG8_STAGE(PG8_SB(1, 1), cB + hstep + kstep, voffB);
        PG8_WAIT_V(6); PG8_BAR;
    } else {
        PG8_STAGE(PG8_SB(0, 0), cB, voffB); PG8_STAGE(PG8_SA(0, 0), cA, voffA); PG8_STAGE(PG8_SB(0, 1), cB + hstep, voffB); PG8_STAGE(PG8_SA(0, 1), cA + hstep, voffA);
        if (wr == 1) PG8_BAR;
        PG8_WAIT_V(4); PG8_BAR;
        PG8_STAGE(PG8_SB(1, 0), cB + kstep, voffB); PG8_STAGE(PG8_SA(1, 0), cA + kstep, voffA); PG8_STAGE(PG8_SB(1, 1), cB + hstep + kstep, voffB);
        PG8_WAIT_V(6); PG8_BAR;
    }
    for (;;) {
        const bool has_next = S.next(ui + 1, nxt);
        const char* nA = has_next ? (const char*)g.A + (size_t)nxt.pm * tstep : cA; const char* nB = has_next ? (const char*)g.Bt + (size_t)nxt.pn * tstep : cB;
        for (int t = 0; t < nt; t += 2) {
            const bool last = (t == nt - 2);
            const char* a1 = cA + (size_t)(t + 1) * kstep;
            const char* a2 = last ? nA : cA + (size_t)(t + 2) * kstep; const char* b2 = last ? nB : cB + (size_t)(t + 2) * kstep;
            const char* a3 = a2 + kstep; const char* b3 = b2 + kstep;
            if (last && has_next) S.a_ready(nxt);
            if constexpr (SP2) {
            PG8_LDB(B0, 0, 0); PG8_LDB(B1, 0, 1); PG8_SCHED; PG8_LDA(At, 0, 0); PG8_STAGE(PG8_SA(1, 1), a1 + hstep, voffA);
            PG8_WAIT_V(8); PG8_WAIT_L(0); PG8_BAR; PG8_MMA(0, 0, At, B0); PG8_MMA(0, 1, At, B1); PG8_BAR; PG8_SCHED;
            PG8_LDA(At, 0, 1); PG8_STAGE(PG8_SB(0, 0), b2, voffB); PG8_STAGE(PG8_SB(0, 1), b2 + hstep, voffB); PG8_STAGE(PG8_SA(0, 0), a2, voffA);
            PG8_WAIT_V(8); PG8_WAIT_L(0); PG8_BAR; PG8_MMA(1, 0, At, B0); PG8_MMA(1, 1, At, B1); PG8_BAR; PG8_SCHED;
            PG8_LDB(B0, 1, 0); PG8_LDB(B1, 1, 1); PG8_SCHED; PG8_LDA(At, 1, 0); PG8_STAGE(PG8_SA(0, 1), a2 + hstep, voffA);
            PG8_WAIT_V(8); PG8_WAIT_L(0); PG8_BAR; PG8_MMA(0, 0, At, B0); PG8_MMA(0, 1, At, B1); PG8_BAR; PG8_SCHED;
            PG8_LDA(At, 1, 1); PG8_STAGE(PG8_SB(1, 0), b3, voffB); PG8_STAGE(PG8_SB(1, 1), b3 + hstep, voffB); PG8_STAGE(PG8_SA(1, 0), a3, voffA);
            PG8_WAIT_V(8); PG8_WAIT_L(0); PG8_BAR; PG8_MMA(1, 0, At, B0); PG8_MMA(1, 1, At, B1); PG8_BAR; PG8_SCHED;
            } else {
            PG8_LDB(B0, 0, 0); PG8_SCHED; PG8_LDA(At, 0, 0); PG8_STAGE(PG8_SA(1, 1), a1 + hstep, voffA);
            PG8_WAIT_L(8); PG8_BAR; PG8_WAIT_L(0); PG8_MMA(0, 0, At, B0); PG8_BAR; PG8_SCHED;
            PG8_LDB(B1, 0, 1); PG8_STAGE(PG8_SB(0, 0), b2, voffB);
            PG8_BAR; PG8_WAIT_L(0); PG8_MMA(0, 1, At, B1); PG8_BAR;
            PG8_LDA(At, 0, 1); PG8_STAGE(PG8_SA(0, 0), a2, voffA);
            PG8_BAR; PG8_WAIT_L(0); PG8_MMA(1, 0, At, B0); PG8_BAR; PG8_SCHED;
            PG8_STAGE(PG8_SB(0, 1), b2 + hstep, voffB);
            PG8_WAIT_V(6); PG8_BAR; PG8_MMA(1, 1, At, B1); PG8_BAR;
            PG8_LDB(B0, 1, 0); PG8_SCHED; PG8_LDA(At, 1, 0); PG8_STAGE(PG8_SA(0, 1), a2 + hstep, voffA);
            PG8_WAIT_L(8); PG8_BAR; PG8_WAIT_L(0); PG8_MMA(0, 0, At, B0); PG8_BAR; PG8_SCHED;
            PG8_LDB(B1, 1, 1); PG8_STAGE(PG8_SB(1, 0), b3, voffB);
            PG8_BAR; PG8_WAIT_L(0); PG8_MMA(0, 1, At, B1); PG8_BAR;
            PG8_LDA(At, 1, 1); PG8_STAGE(PG8_SA(1, 0), a3, voffA);
            PG8_BAR; PG8_WAIT_L(0); PG8_MMA(1, 0, At, B0); PG8_BAR; PG8_SCHED;
            PG8_STAGE(PG8_SB(1, 1), b3 + hstep, voffB);
            PG8_WAIT_V(6); PG8_BAR; PG8_MMA(1, 1, At, B1); PG8_BAR;
            }
        }
        if constexpr (ALIGN_EPI) { if (wr == 0) PG8_BAR; }
        if constexpr (!Epi::AFTER_DRAIN) { E(acc, cur, wr, wc, fr, fq); S.done(cur); }
        if (!has_next) break;
#pragma unroll
        for (int a = 0; a < 2; ++a)
#pragma unroll
            for (int b = 0; b < 2; ++b)
#pragma unroll
                for (int m = 0; m < 4; ++m)
#pragma unroll
                    for (int n = 0; n < 2; ++n) acc[a][b][m][n] = (f32x4){0.f, 0.f, 0.f, 0.f};
        cur = nxt; cA = nA; cB = nB; ++ui;
        if constexpr (ALIGN_EPI) { if (wr == 1) PG8_BAR; }
    }
    PG8_WAIT_V(0);
    if constexpr (!ALIGN_EPI) { if (wr == 0) PG8_BAR; }
    PG8_BAR;
    if constexpr (Epi::AFTER_DRAIN) { E.fused(acc, cur, wr, wc, fr, fq, lds, wid, lane); S.done(cur); }
#undef PG8_SA
#undef PG8_SB
#undef PG8_STAGE
#undef PG8_LDA
#undef PG8_LDB
#undef PG8_MMA
#undef PG8_WAIT_V
#undef PG8_WAIT_L
#undef PG8_BAR
#undef PG8_SCHED
}
}

constexpr int BATCH = 8, SEQ = 2048, DM = 2048, MROWS = BATCH * SEQ, DIN = 7680, DEPTH = 2;
constexpr int C_AQ = 0, C_AK = 512, C_AV = 1024, C_AG = 1536, C_BQ = 2048, C_BK = 3072, C_BV = 4096, C_BG = 5120, C_CU = 6144, C_CGLU = 6656, C_CG = 7168;
constexpr int Y_A = 0, Y_B = 512, Y_C = 1536;
constexpr int DC = 512, CONVW = 31;
constexpr float LN_EPS = 1e-5f;
constexpr float ALPHA = 1.41421356237309515f;
constexpr int NWAVES = 8;
constexpr int LDS_BYTES = 163840;

constexpr size_t MiB = 1u << 20;
constexpr size_t WS_CTL = 0, CTL_ZERO_BYTES = 64 * 1024;
constexpr size_t WS_TAB = 1 * MiB;
constexpr size_t TAB_BIASA = 0, TAB_BIASB = 32 * 1024, TAB_LAM = 64 * 1024;
constexpr size_t WS_WIN = 2 * MiB;
constexpr size_t WS_WOUT = 62 * MiB;
constexpr size_t WS_WPW = 78 * MiB;
constexpr size_t WS_XB = 80 * MiB;
constexpr size_t WS_Y = 144 * MiB;
constexpr size_t WS_PROJ = 208 * MiB;
constexpr size_t WS_BST = 448 * MiB;
constexpr size_t WS_END = 448 * MiB + 256 * (size_t)(256 * 528);

#define GAS __attribute__((address_space(1)))
#define LAS __attribute__((address_space(3)))
typedef unsigned short bf16;
typedef unsigned v4u __attribute__((ext_vector_type(4)));
typedef unsigned v2u __attribute__((ext_vector_type(2)));
typedef float f32x4 __attribute__((ext_vector_type(4)));
#define LDS_WAIT() asm volatile("s_waitcnt lgkmcnt(0)" ::: "memory")
#define VM_WAIT() asm volatile("s_waitcnt vmcnt(0)" ::: "memory")

__device__ __forceinline__ unsigned f2bf(float f) { unsigned u = __builtin_bit_cast(unsigned, f); return (u + 0x7fffu + ((u >> 16) & 1u)) >> 16; }
__device__ __forceinline__ unsigned pk2(float lo, float hi) { return f2bf(lo) | (f2bf(hi) << 16); }
__device__ __forceinline__ float bflo(unsigned u) { return __uint_as_float(u << 16); }
__device__ __forceinline__ float bfhi(unsigned u) { return __uint_as_float(u & 0xffff0000u); }
template <int CTRL> __device__ __forceinline__ float dpp_f(float v) { return __uint_as_float((unsigned)__builtin_amdgcn_mov_dpp((int)__float_as_uint(v), CTRL, 0xF, 0xF, true)); }
#define DPP_XOR1 0xB1
#define DPP_XOR2 0x4E
#define DPP_HMIR 0x141
#define DPP_RMIR 0x140
__device__ __forceinline__ float xor16_sum(float v) { auto r = __builtin_amdgcn_permlane16_swap(__float_as_uint(v), __float_as_uint(v), false, false); return __uint_as_float(r[0]) + __uint_as_float(r[1]); }
__device__ __forceinline__ float xor32_sum(float v) { auto r = __builtin_amdgcn_permlane32_swap(__float_as_uint(v), __float_as_uint(v), false, false); return __uint_as_float(r[0]) + __uint_as_float(r[1]); }
__device__ __forceinline__ float xor16_max(float v) { auto r = __builtin_amdgcn_permlane16_swap(__float_as_uint(v), __float_as_uint(v), false, false); return fmaxf(__uint_as_float(r[0]), __uint_as_float(r[1])); }
__device__ __forceinline__ float xor32_max(float v) { auto r = __builtin_amdgcn_permlane32_swap(__float_as_uint(v), __float_as_uint(v), false, false); return fmaxf(__uint_as_float(r[0]), __uint_as_float(r[1])); }
__device__ __forceinline__ float quad_sum(float v) { v += dpp_f<DPP_XOR1>(v); v += dpp_f<DPP_XOR2>(v); return v; }
__device__ __forceinline__ float oct_sum(float v) { v = quad_sum(v); v += dpp_f<DPP_HMIR>(v); return v; }
__device__ __forceinline__ float wave_sum(float v) { v = oct_sum(v); v += dpp_f<DPP_RMIR>(v); v = xor16_sum(v); return xor32_sum(v); }
__device__ __forceinline__ float wave_max(float v) {
    v = fmaxf(v, dpp_f<DPP_XOR1>(v)); v = fmaxf(v, dpp_f<DPP_XOR2>(v)); v = fmaxf(v, dpp_f<DPP_HMIR>(v)); v = fmaxf(v, dpp_f<DPP_RMIR>(v)); v = xor16_max(v); return xor32_max(v);
}
__device__ __forceinline__ float dot8(v4u a, v4u b, float s) {
    s += bflo(a.x) * bflo(b.x); s += bfhi(a.x) * bfhi(b.x); s += bflo(a.y) * bflo(b.y); s += bfhi(a.y) * bfhi(b.y);
    s += bflo(a.z) * bflo(b.z); s += bfhi(a.z) * bfhi(b.z); s += bflo(a.w) * bflo(b.w); s += bfhi(a.w) * bfhi(b.w);
    return s;
}
__device__ __forceinline__ float silu_f(float x) { return x / (1.f + __expf(-x)); }
__device__ __forceinline__ float sigmoid_f(float x) { return 1.f / (1.f + __expf(-x)); }
__device__ __forceinline__ int t5_bucket(int d) {
    if (d < 16) return d;
    int v = 16 + (int)(logf((float)d * (1.f / 16.f)) / 4.852030263919617f * 16.f);
    return v < 31 ? v : 31;
}
__host__ __device__ __forceinline__ float lam_init_of(int layer) { return layer == 0 ? 0.2f : 0.35550906759f; }

struct EpiHeadMajor {
    static constexpr bool PERM = true, AFTER_DRAIN = false;
    bf16* O;
    __device__ __forceinline__ void operator()(const pg8::f32x4 (&acc)[2][2][4][2], const pg8::Unit& u, int wr, int wc, int fr, int fq) const {
        const int row0 = u.pm * pg8::BM + wr * 64 + fr;
#pragma unroll
        for (int bj = 0; bj < 2; ++bj) { bf16* blk = O + (size_t)(2 * u.pn + bj) * (MROWS * 128) + wc * 32 + 8 * fq;
#pragma unroll
            for (int ai = 0; ai < 2; ++ai)
#pragma unroll
                for (int m = 0; m < 4; ++m) { const pg8::f32x4 v0 = acc[ai][bj][m][0], v1 = acc[ai][bj][m][1];
                    pg8::u32x4 w; w.x = pg8::cvt_pk_bf16(v0[0], v0[1]); w.y = pg8::cvt_pk_bf16(v0[2], v0[3]); w.z = pg8::cvt_pk_bf16(v1[0], v1[1]); w.w = pg8::cvt_pk_bf16(v1[2], v1[3]);
                    *(pg8::u32x4*)(blk + (size_t)(row0 + ai * pg8::HALF + m * 16) * 128) = w; } }
    }
};

struct EpiResid {
    static constexpr bool PERM = false, AFTER_DRAIN = false;
    const float* res; float* out; int ldc; float alpha;
    __device__ __forceinline__ void operator()(const pg8::f32x4 (&acc)[2][2][4][2], const pg8::Unit& u, int wr, int wc, int fr, int fq) const {
        const int row0 = u.pm * pg8::BM + wr * 64 + fr, col0 = u.pn * pg8::BM + wc * 32 + 4 * fq;
#pragma unroll
        for (int ai = 0; ai < 2; ++ai)
#pragma unroll
            for (int m = 0; m < 4; ++m) { const size_t off = (size_t)(row0 + ai * pg8::HALF + m * 16) * ldc + col0;
                pg8::f32x4 r[2][2];
#pragma unroll
                for (int bj = 0; bj < 2; ++bj)
#pragma unroll
                    for (int n = 0; n < 2; ++n) r[bj][n] = *(const pg8::f32x4*)(res + off + bj * pg8::HALF + n * 16);
#pragma unroll
                for (int bj = 0; bj < 2; ++bj)
#pragma unroll
                    for (int n = 0; n < 2; ++n) *(pg8::f32x4*)(out + off + bj * pg8::HALF + n * 16) = r[bj][n] * alpha + acc[ai][bj][m][n];
                asm volatile("" ::: "memory"); }
    }
};

struct Frame {
    LAS unsigned char* lds;
    int G, wave;
    const float *x, *w_in, *diff_lambda, *head_gain, *conv_dw, *conv_b, *conv_ln_g, *conv_ln_b, *conv_pw, *w_out, *ln_g, *ln_b, *rel_bias;
    float* out;
    bf16 *win_t, *wout_t, *wpw_t, *xb, *ymix, *proj;
    float *biasA, *biasB, *lamv;
    unsigned* ctl;
    unsigned char* bstate;
};

__device__ __forceinline__ int lane_id_v() { unsigned l; asm volatile("v_mbcnt_lo_u32_b32 %0, -1, 0\n\tv_mbcnt_hi_u32_b32 %0, -1, %0" : "=v"(l)); return (int)l; }
#define PHASE_IDS() int wave_ = F.wave; asm volatile("" : "+s"(wave_)); int lane_ = lane_id_v(); const int wave = wave_, lane = lane_, tid = wave * 64 + lane; (void)tid; (void)lane; (void)wave
__device__ __forceinline__ void p0_transpose_item(const float* W, int K, int N, bf16* WT, LAS float* scr, int item, int lane) {
    const int nblk = N / 32, kb = item / nblk, nb = item % nblk, k0 = 64 * kb, n0 = 32 * nb;
#pragma unroll 8
    for (int i = 0; i < 32; ++i) { const int kk = 2 * i + (lane >> 5); scr[kk * 33 + (lane & 31)] = W[(size_t)(k0 + kk) * N + n0 + (lane & 31)]; }
    LDS_WAIT(); asm volatile("" ::: "memory");
    const int c = lane & 7;
#pragma unroll
    for (int j = 0; j < 4; ++j) { const int n = (lane >> 3) + 8 * j; const LAS float* s = scr + (8 * c) * 33 + n;
        v4u o; o.x = pk2(s[0 * 33], s[1 * 33]); o.y = pk2(s[2 * 33], s[3 * 33]); o.z = pk2(s[4 * 33], s[5 * 33]); o.w = pk2(s[6 * 33], s[7 * 33]);
        *(GAS v4u*)(WT + (size_t)(n0 + n) * K + k0 + 8 * c) = o; }
    LDS_WAIT(); asm volatile("" ::: "memory");
}

__device__ __forceinline__ void p0_prologue(Frame& F) {
    PHASE_IDS();
    LAS float* scr = (LAS float*)(F.lds + wave * 16384);
    const int gw = blockIdx.x * NWAVES + wave, NGW = F.G * NWAVES;
    constexpr int I_IN = (DM / 64) * (DIN / 32), I_OUT = (DM / 64) * (DM / 32), I_PW = (DC / 64) * (DC / 32);
    constexpr int NITEMS = DEPTH * (I_IN + I_OUT + I_PW);
    for (int it = gw; it < NITEMS; it += NGW) {
        int r = it;
        if (r < DEPTH * I_IN) { const int l = r / I_IN; r -= l * I_IN; p0_transpose_item(F.w_in + (size_t)l * DM * DIN, DM, DIN, F.win_t + (size_t)l * DIN * DM, scr, r, lane); continue; }
        r -= DEPTH * I_IN;
        if (r < DEPTH * I_OUT) { const int l = r / I_OUT; r -= l * I_OUT; p0_transpose_item(F.w_out + (size_t)l * DM * DM, DM, DM, F.wout_t + (size_t)l * DM * DM, scr, r, lane); continue; }
        r -= DEPTH * I_OUT;
        { const int l = r / I_PW; r -= l * I_PW; p0_transpose_item(F.conv_pw + (size_t)l * DC * DC, DC, DC, F.wpw_t + (size_t)l * DC * DC, scr, r, lane); }
    }
    { const size_t n8 = (size_t)MROWS * DM / 8;
      for (size_t i = (size_t)gw * 64 + lane; i < n8; i += (size_t)NGW * 64) {
          const f32x4 a = *(const GAS f32x4*)(F.x + i * 8), b = *(const GAS f32x4*)(F.x + i * 8 + 4);
          v4u o; o.x = pk2(a.x, a.y); o.y = pk2(a.z, a.w); o.z = pk2(b.x, b.y); o.w = pk2(b.z, b.w);
          *(GAS v4u*)(F.xb + i * 8) = o; } }
    { const int gt = blockIdx.x * (NWAVES * 64) + tid, NT = F.G * NWAVES * 64;
      for (int i = gt; i < 4 * 2048; i += NT) { const int h = i >> 11, d = i & 2047; F.biasA[i] = F.rel_bias[t5_bucket(d) * 12 + h]; }
      for (int i = gt; i < 3 * 8 * 132; i += NT) { const int p = i / (8 * 132), h = (i / 132) % 8, j = i % 132; const int dil = p == 0 ? 1 : (p == 1 ? 4 : 16);
          F.biasB[i] = (j <= 128) ? F.rel_bias[t5_bucket(j * dil) * 12 + 4 + h] : 0.f; }
      if (gt < DEPTH) { const float* lv = F.diff_lambda + gt * 4 * 64; float s0 = 0.f, s1 = 0.f;
          for (int i = 0; i < 64; ++i) { s0 += lv[i] * lv[64 + i]; s1 += lv[128 + i] * lv[192 + i]; }
          F.lamv[gt] = expf(s0) - expf(s1) + lam_init_of(gt); } }
}

__device__ __forceinline__ void naive_mixer_a(Frame& F, int layer) {
    PHASE_IDS();
    LAS float* sc = (LAS float*)(F.lds) + wave * 4096;
    const float lam = F.lamv[layer], li = lam_init_of(layer);
    const int gw = blockIdx.x * NWAVES + wave, NGW = F.G * NWAVES;
    for (int item = gw; item < MROWS * 4; item += NGW) {
        const int h = item & 3, bt = item >> 2, t = bt & (SEQ - 1), b = bt >> 11;
        const bf16* base = F.proj + (size_t)(b * SEQ) * DIN;
        const bf16* qp = base + (size_t)t * DIN + C_AQ + h * 128;
        v4u q[16];
#pragma unroll
        for (int i = 0; i < 16; ++i) q[i] = *(const GAS v4u*)(qp + i * 8);
        float m0 = -INFINITY, m1 = -INFINITY;
        for (int k = lane; k <= t; k += 64) {
            const bf16* kp = base + (size_t)k * DIN + C_AK + h * 128;
            float s0 = 0.f, s1 = 0.f;
#pragma unroll
            for (int i = 0; i < 8; ++i) s0 = dot8(q[i], *(const GAS v4u*)(kp + i * 8), s0);
#pragma unroll
            for (int i = 8; i < 16; ++i) s1 = dot8(q[i], *(const GAS v4u*)(kp + i * 8), s1);
            const float bias = F.biasA[h * 2048 + (t - k)];
            s0 = s0 * 0.125f + bias; s1 = s1 * 0.125f + bias;
            sc[k] = s0; sc[2048 + k] = s1; m0 = fmaxf(m0, s0); m1 = fmaxf(m1, s1);
        }
        m0 = wave_max(m0); m1 = wave_max(m1);
        float l0 = 0.f, l1 = 0.f;
        for (int k = lane; k <= t; k += 64) { const float p0 = __expf(sc[k] - m0), p1 = __expf(sc[2048 + k] - m1); sc[k] = p0; sc[2048 + k] = p1; l0 += p0; l1 += p1; }
        l0 = wave_sum(l0); l1 = wave_sum(l1);
        const float i0 = 1.f / l0, i1 = lam / l1;
        for (int k = lane; k <= t; k += 64) sc[k] = sc[k] * i0 - sc[2048 + k] * i1;
        LDS_WAIT(); asm volatile("" ::: "memory");
        float a0 = 0.f, a1 = 0.f;
        const bf16* vp = base + C_AV + h * 128 + 2 * lane;
        for (int k = 0; k <= t; ++k) { const float a = sc[k]; const unsigned v = *(const GAS unsigned*)(vp + (size_t)k * DIN); a0 += a * bflo(v); a1 += a * bfhi(v); }
        const float ss = wave_sum(a0 * a0 + a1 * a1);
        const float r = rsqrtf(ss * (1.f / 128.f) + LN_EPS) * (1.f - li);
        const float g0 = F.head_gain[layer * 128 + 2 * lane], g1 = F.head_gain[layer * 128 + 2 * lane + 1];
        const unsigned ag = *(const GAS unsigned*)(base + (size_t)t * DIN + C_AG + h * 128 + 2 * lane);
        const float o0 = a0 * r * g0 * silu_f(bflo(ag)), o1 = a1 * r * g1 * silu_f(bfhi(ag));
        *(GAS unsigned*)(F.ymix + (size_t)(b * SEQ + t) * DM + Y_A + h * 128 + 2 * lane) = pk2(o0, o1);
        LDS_WAIT(); asm volatile("" ::: "memory");
    }
}

__device__ __forceinline__ void naive_mixer_b(Frame& F, int layer) {
    PHASE_IDS();
    LAS float* sc = (LAS float*)(F.lds) + wave * 512;
    const int gw = blockIdx.x * NWAVES + wave, NGW = F.G * NWAVES;
    const float scale = 0.08838834764831845f;
    for (int item = gw; item < MROWS * 8; item += NGW) {
        const int h = item & 7, bt = item >> 3, t = bt & (SEQ - 1), b = bt >> 11;
        const bf16* base = F.proj + (size_t)(b * SEQ) * DIN;
        const bf16* qp = base + (size_t)t * DIN + C_BQ + h * 128;
        v4u q[16];
#pragma unroll
        for (int i = 0; i < 16; ++i) q[i] = *(const GAS v4u*)(qp + i * 8);
        float m = -INFINITY;
#pragma unroll
        for (int p = 0; p < 3; ++p) { const int dil = p == 0 ? 1 : (p == 1 ? 4 : 16);
            for (int j = lane; j <= 128; j += 64) { const int tk = t - j * dil; float s = -INFINITY;
                if (tk >= 0) { const bf16* kp = base + (size_t)tk * DIN + C_BK + h * 128; s = 0.f;
#pragma unroll
                    for (int i = 0; i < 16; ++i) s = dot8(q[i], *(const GAS v4u*)(kp + i * 8), s);
                    s = s * scale + F.biasB[(p * 8 + h) * 132 + j]; }
                sc[p * 132 + j] = s; m = fmaxf(m, s); } }
        m = wave_max(m);
        float l = 0.f;
#pragma unroll
        for (int p = 0; p < 3; ++p) for (int j = lane; j <= 128; j += 64) { const float e = __expf(sc[p * 132 + j] - m); sc[p * 132 + j] = e; l += e; }
        l = wave_sum(l);
        LDS_WAIT(); asm volatile("" ::: "memory");
        float a0 = 0.f, a1 = 0.f;
        const bf16* vp = base + C_BV + h * 128 + 2 * lane;
#pragma unroll
        for (int p = 0; p < 3; ++p) { const int dil = p == 0 ? 1 : (p == 1 ? 4 : 16); int jmax = t / dil; jmax = jmax < 128 ? jmax : 128;
            for (int j = 0; j <= jmax; ++j) { const float a = sc[p * 132 + j]; const unsigned v = *(const GAS unsigned*)(vp + (size_t)(t - j * dil) * DIN); a0 += a * bflo(v); a1 += a * bfhi(v); } }
        const float il = 1.f / l;
        const unsigned bg = *(const GAS unsigned*)(base + (size_t)t * DIN + C_BG + h * 128 + 2 * lane);
        *(GAS unsigned*)(F.ymix + (size_t)(b * SEQ + t) * DM + Y_B + h * 128 + 2 * lane) = pk2(a0 * il * silu_f(bflo(bg)), a1 * il * silu_f(bfhi(bg)));
        LDS_WAIT(); asm volatile("" ::: "memory");
    }
}

__device__ __forceinline__ void naive_mixer_c(Frame& F, int layer) {
    PHASE_IDS();
    LAS float* hb = (LAS float*)(F.lds) + wave * 512;
    const int gw = blockIdx.x * NWAVES + wave, NGW = F.G * NWAVES, c0 = lane * 8;
    const float* dw = F.conv_dw + (size_t)layer * CONVW * DC; const float* pw = F.conv_pw + (size_t)layer * DC * DC;
    for (int item = gw; item < MROWS; item += NGW) {
        const int t = item & (SEQ - 1), b = item >> 11;
        const bf16* base = F.proj + (size_t)(b * SEQ) * DIN;
        float acc[8];
#pragma unroll
        for (int i = 0; i < 8; ++i) acc[i] = F.conv_b[layer * DC + c0 + i];
        for (int j = 0; j < CONVW; ++j) { const int tk = t - (CONVW - 1) + j; if (tk < 0) continue;
            const v4u u = *(const GAS v4u*)(base + (size_t)tk * DIN + C_CU + c0), g = *(const GAS v4u*)(base + (size_t)tk * DIN + C_CGLU + c0);
            const f32x4 w0 = *(const GAS f32x4*)(dw + j * DC + c0), w1 = *(const GAS f32x4*)(dw + j * DC + c0 + 4);
            acc[0] += w0.x * (bflo(u.x) * sigmoid_f(bflo(g.x))); acc[1] += w0.y * (bfhi(u.x) * sigmoid_f(bfhi(g.x)));
            acc[2] += w0.z * (bflo(u.y) * sigmoid_f(bflo(g.y))); acc[3] += w0.w * (bfhi(u.y) * sigmoid_f(bfhi(g.y)));
            acc[4] += w1.x * (bflo(u.z) * sigmoid_f(bflo(g.z))); acc[5] += w1.y * (bfhi(u.z) * sigmoid_f(bfhi(g.z)));
            acc[6] += w1.z * (bflo(u.w) * sigmoid_f(bflo(g.w))); acc[7] += w1.w * (bfhi(u.w) * sigmoid_f(bfhi(g.w))); }
        float s = 0.f;
#pragma unroll
        for (int i = 0; i < 8; ++i) s += acc[i];
        const float mean = wave_sum(s) * (1.f / DC); float s2 = 0.f;
#pragma unroll
        for (int i = 0; i < 8; ++i) { acc[i] -= mean; s2 += acc[i] * acc[i]; }
        const float rstd = rsqrtf(wave_sum(s2) * (1.f / DC) + LN_EPS);
#pragma unroll
        for (int i = 0; i < 8; ++i) { const float hn = acc[i] * rstd * F.conv_ln_g[layer * DC + c0 + i] + F.conv_ln_b[layer * DC + c0 + i]; hb[c0 + i] = silu_f(hn); }
        LDS_WAIT(); asm volatile("" ::: "memory");
        float o[8];
#pragma unroll
        for (int i = 0; i < 8; ++i) o[i] = 0.f;
        for (int c = 0; c < DC; ++c) { const float hv = hb[c]; const f32x4 w0 = *(const GAS f32x4*)(pw + (size_t)c * DC + c0), w1 = *(const GAS f32x4*)(pw + (size_t)c * DC + c0 + 4);
            o[0] += hv * w0.x; o[1] += hv * w0.y; o[2] += hv * w0.z; o[3] += hv * w0.w; o[4] += hv * w1.x; o[5] += hv * w1.y; o[6] += hv * w1.z; o[7] += hv * w1.w; }
        const v4u cg = *(const GAS v4u*)(base + (size_t)t * DIN + C_CG + c0);
        v4u ov; ov.x = pk2(o[0] * silu_f(bflo(cg.x)), o[1] * silu_f(bfhi(cg.x))); ov.y = pk2(o[2] * silu_f(bflo(cg.y)), o[3] * silu_f(bfhi(cg.y)));
        ov.z = pk2(o[4] * silu_f(bflo(cg.z)), o[5] * silu_f(bfhi(cg.z))); ov.w = pk2(o[6] * silu_f(bflo(cg.w)), o[7] * silu_f(bfhi(cg.w)));
        *(GAS v4u*)(F.ymix + (size_t)(b * SEQ + t) * DM + Y_C + c0) = ov;
        LDS_WAIT(); asm volatile("" ::: "memory");
    }
}

__device__ __forceinline__ void ln_phase(Frame& F, int layer, bool write_xb) {
    PHASE_IDS();
    const int gw = blockIdx.x * NWAVES + wave, NGW = F.G * NWAVES;
    const float* g = F.ln_g + layer * DM; const float* bb = F.ln_b + layer * DM;
    for (int row = gw; row < MROWS; row += NGW) {
        GAS f32x4* xr = (GAS f32x4*)(F.out + (size_t)row * DM) + lane;
        f32x4 v[8]; float s = 0.f;
#pragma unroll
        for (int j = 0; j < 8; ++j) { v[j] = xr[64 * j]; s += (v[j].x + v[j].y) + (v[j].z + v[j].w); }
        const float mean = wave_sum(s) * (1.f / DM); float s2 = 0.f;
#pragma unroll
        for (int j = 0; j < 8; ++j) { v[j] = v[j] - mean; s2 += (v[j].x * v[j].x + v[j].y * v[j].y) + (v[j].z * v[j].z + v[j].w * v[j].w); }
        const float rstd = rsqrtf(wave_sum(s2) * (1.f / DM) + LN_EPS);
#pragma unroll
        for (int j = 0; j < 8; ++j) { const int c = 4 * lane + 256 * j; const f32x4 gv = *(const GAS f32x4*)(g + c), bv = *(const GAS f32x4*)(bb + c);
            const f32x4 o = v[j] * rstd * gv + bv; xr[64 * j] = o;
            if (write_xb) { v2u w; w.x = pk2(o.x, o.y); w.y = pk2(o.z, o.w); *(GAS v2u*)(F.xb + (size_t)row * DM + c) = w; } }
    }
}


#define RLX_AGENT __ATOMIC_RELAXED, __HIP_MEMORY_SCOPE_AGENT
#define XB_TMO      128
#define XB_XCNT(j)  (256  + 64 * (j))
#define XB_XSUB(j)  (1280 + 64 * (j))
#define XB_XGEN(j)  (2304 + 64 * (j))
#define XB_TOP      3328
#define XB_TOPGEN   3392
#define XCD_BAR_WORDS 3456
#define XB_SPIN_CAP (1u << 18)

__device__ __forceinline__ unsigned xb_ld(unsigned* p)              { return __hip_atomic_load(p, __ATOMIC_RELAXED, __HIP_MEMORY_SCOPE_AGENT); }
__device__ __forceinline__ unsigned xb_add(unsigned* p, unsigned v) { return __hip_atomic_fetch_add(p, v, __ATOMIC_RELAXED, __HIP_MEMORY_SCOPE_AGENT); }
__device__ __forceinline__ unsigned xb_xcc_id() { return (unsigned)__builtin_amdgcn_s_getreg((3 << 11) | 20) & 0xFu; }
#define XB_SPIN(cond, bar) do { unsigned _sp = 0; while (cond) { __builtin_amdgcn_s_sleep(1); \
    if ((++_sp & 255u) == 0u) { if (xb_ld(&(bar)[XB_TMO])) break; if (_sp > XB_SPIN_CAP) { atomicAdd(&(bar)[XB_TMO], 1u); break; } } } } while (0)

struct XcdBarrier {
    unsigned* bar; unsigned x;
    volatile LAS unsigned* st;
};

__device__ __forceinline__ XcdBarrier xcd_barrier_post(unsigned* bar, volatile LAS unsigned* st, bool t0) {
    XcdBarrier b; b.bar = bar; b.x = xb_xcc_id(); b.st = st;
    if (t0) (void)xb_add(&bar[XB_XCNT(b.x)], 1u);
    return b;
}
__device__ __forceinline__ void xcd_barrier_complete(unsigned* bar, unsigned x, unsigned& nloc, unsigned& nx) {
    const unsigned G = gridDim.x * gridDim.y * gridDim.z;
    unsigned sum, cnt, mine, sp = 0u;
    for (;;) {
        sum = 0u; cnt = 0u; mine = 0u;
#pragma unroll
        for (unsigned j = 0; j < 16; ++j) { const unsigned c = xb_ld(&bar[XB_XCNT(j)]); sum += c; cnt += (c > 0u) ? 1u : 0u; mine = (j == x) ? c : mine; }
        if (sum == G) break;
        __builtin_amdgcn_s_sleep(1);
        if ((++sp & 255u) == 0u) { if (xb_ld(&bar[XB_TMO])) break; if (sp > XB_SPIN_CAP) { atomicAdd(&bar[XB_TMO], 1u); break; } }
    }
    nloc = mine > 0u ? mine : 1u; nx = cnt > 0u ? cnt : 1u;
}

__device__ __forceinline__ void xcd_barrier(const XcdBarrier& b, bool t0) {
    asm volatile("s_waitcnt vmcnt(0)" ::: "memory");
    __syncthreads();
    if (t0) {
        unsigned* bar = b.bar;
        __builtin_amdgcn_s_waitcnt(0);
        unsigned nloc = b.st[0], nx = b.st[1];
        if (nloc == 0u) { xcd_barrier_complete(bar, b.x, nloc, nx); b.st[0] = nloc; b.st[1] = nx; }
        const unsigned old = xb_add(&bar[XB_XSUB(b.x)], 1u);
        const unsigned gen = old / nloc;
        if (old + 1u == (gen + 1u) * nloc) {
            __builtin_amdgcn_fence(__ATOMIC_RELEASE, "agent");
            asm volatile("s_waitcnt vmcnt(0)" ::: "memory");
            const unsigned og = xb_add(&bar[XB_TOP], 1u);
            const unsigned tg = og / nx;
            if (og + 1u == (tg + 1u) * nx) xb_add(&bar[XB_TOPGEN], 1u);
            else XB_SPIN(xb_ld(&bar[XB_TOPGEN]) == tg, bar);
            __builtin_amdgcn_fence(__ATOMIC_ACQUIRE, "agent");
            xb_add(&bar[XB_XGEN(b.x)], 1u);
            asm volatile("s_waitcnt vmcnt(0)" ::: "memory");
        } else {
            XB_SPIN(xb_ld(&bar[XB_XGEN(b.x)]) == gen, bar);
            __builtin_amdgcn_fence(__ATOMIC_ACQUIRE, "agent");
            asm volatile("s_waitcnt vmcnt(0)" ::: "memory");
        }
    }
    __syncthreads();
}

typedef short bf16x8 __attribute__((ext_vector_type(8)));
typedef float f32x16 __attribute__((ext_vector_type(16)));
typedef short s16x4 __attribute__((ext_vector_type(4)));
typedef float f32x2 __attribute__((ext_vector_type(2)));
#define MFMA32(a, b, c) __builtin_amdgcn_mfma_f32_32x32x16_bf16((a), (b), (c), 0, 0, 0)
constexpr int AT_BUF = 8192;
constexpr int AT_WAVE = 2 * AT_BUF;
constexpr int AT_PAD = 32;
constexpr float AT_MASK = -3.0e38f, AT_MINIT = -1.0e30f;
constexpr float LOG2E = 1.4426950408889634f;
#define AT_WAITV(n) asm volatile("s_waitcnt vmcnt(" #n ")" ::: "memory")
#define AT_WAITL() asm volatile("s_waitcnt lgkmcnt(0)" ::: "memory")

__device__ __forceinline__ s16x4 ds_tr16(LAS const unsigned char* p) {
    typedef short v4i16_t __attribute__((ext_vector_type(4)));
    return __builtin_bit_cast(s16x4, __builtin_amdgcn_ds_read_tr16_b64_v4i16((LAS v4i16_t*)p));
}
__device__ __forceinline__ unsigned cvtpk(float lo, float hi) { typedef float f2 __attribute__((ext_vector_type(2))); typedef __bf16 b2 __attribute__((ext_vector_type(2))); f2 v = {lo, hi}; b2 b = __builtin_convertvector(v, b2); return __builtin_bit_cast(unsigned, b); }

struct RowMap { int p0, str, hi; };
struct LaneOff { unsigned k[4], v; };
__device__ __forceinline__ LaneOff lane_off(int str, int lane) {
    const int rl = lane >> 4, s = lane & 15; LaneOff o;
#pragma unroll
    for (int i = 0; i < 4; ++i) o.k[i] = (unsigned)(rl * str * 128 + ((s ^ (4 * i + rl)) * 8)) * 2u;
    o.v = (unsigned)(rl * str * 128 + ((s ^ (rl << 2)) * 8)) * 2u;
    return o;
}
__device__ __forceinline__ void glds16(const GAS char* sbase, unsigned voff, unsigned ldsaddr) {
    unsigned keep;
    asm volatile("s_nop 4\n\ts_mov_b32 %0, m0\n\ts_mov_b32 m0, %3\n\ts_nop 0\n\tglobal_load_lds_dwordx4 %1, %2\n\ts_mov_b32 m0, %0" : "=&s"(keep) : "v"(voff), "s"(sbase), "s"(ldsaddr) : "memory");
}
template <bool ISV> __device__ __forceinline__ void glds_tile(LAS unsigned char* buf, const bf16* base, int col, const RowMap rm, const LaneOff& lo) {
    const unsigned long long ub64 = (unsigned long long)(uintptr_t)(base + (size_t)col * (MROWS * 128) + (size_t)rm.p0 * 128);
    const GAS char* ub = (const GAS char*)(uintptr_t)(((unsigned long long)(unsigned)__builtin_amdgcn_readfirstlane((int)(ub64 >> 32)) << 32) | (unsigned)__builtin_amdgcn_readfirstlane((int)ub64));
    const unsigned la = (unsigned)__builtin_amdgcn_readfirstlane((int)(unsigned)(uintptr_t)buf);
#pragma unroll
    for (int i = 0; i < 8; ++i) { const unsigned uo = (unsigned)((4 * (i & 3) * rm.str + (i >> 2) * rm.hi) * 128) * 2u;
        glds16(ub + uo, ISV ? lo.v : lo.k[i & 3], la + i * 1024); }
}
__device__ __forceinline__ bf16x8 kimg_frag(LAS const unsigned char* img, int c, int lane) {
    const int r = lane & 31;
    return *(LAS const bf16x8*)(img + r * 256 + (((2 * c + (lane >> 5)) ^ (r & 15)) << 4));
}

template <int NS> struct AttnState { f32x16 o[NS][4]; float m[NS], l[NS]; };

template <int NS, class AfterK>
__device__ __forceinline__ void attn_scores(f32x16 (&p)[NS], const bf16x8 (&qf)[8], LAS const unsigned char* kimg, int lane, const AfterK& after_k) {
#pragma unroll
    for (int s = 0; s < NS; ++s) {
        constexpr int NC = 8 / NS;
        bf16x8 kf[NC];
#pragma unroll
        for (int c = 0; c < NC; ++c) kf[c] = kimg_frag(kimg, s * NC + c, lane);
        if (s == NS - 1) { AT_WAITL(); __builtin_amdgcn_sched_barrier(0); after_k(); }
        f32x16 acc = {0.f, 0.f, 0.f, 0.f, 0.f, 0.f, 0.f, 0.f, 0.f, 0.f, 0.f, 0.f, 0.f, 0.f, 0.f, 0.f};
#pragma unroll
        for (int c = 0; c < NC; ++c) acc = MFMA32(kf[c], qf[s * NC + c], acc);
        p[s] = acc;
    }
}
template <int NS>
__device__ __forceinline__ void attn_softmax(AttnState<NS>& S, f32x16 (&p)[NS], unsigned (&pb)[NS][2][4], LAS const float* tab, int jlo, int jhi, float c1) {
    { LAS const float* tl = tab + jlo; LAS const float* th = tab + jhi;
#pragma unroll
      for (int r = 0; r < 16; ++r) { const float bias = (r < 8 ? tl : th)[(r & 3) + 8 * (r >> 2)];
#pragma unroll
          for (int s = 0; s < NS; ++s) p[s][r] = p[s][r] * c1 + bias; } }
#pragma unroll
    for (int s = 0; s < NS; ++s) {
        float mx = AT_MASK;
#pragma unroll
        for (int r = 0; r < 16; ++r) mx = fmaxf(mx, p[s][r]);
        mx = xor32_max(mx);
        const float mn = fmaxf(S.m[s], mx);
        if (__any(mn > S.m[s])) {
            const float al = __builtin_amdgcn_exp2f(S.m[s] - mn);
            S.l[s] *= al;
#pragma unroll
            for (int d = 0; d < 4; ++d)
#pragma unroll
                for (int r = 0; r < 16; ++r) S.o[s][d][r] *= al;
            S.m[s] = mn;
        }
        float ls = 0.f;
#pragma unroll
        for (int r = 0; r < 16; ++r) { p[s][r] = __builtin_amdgcn_exp2f(p[s][r] - mn); ls += p[s][r]; }
        S.l[s] += ls;
#pragma unroll
        for (int k = 0; k < 2; ++k)
#pragma unroll
            for (int j = 0; j < 4; ++j) pb[s][k][j] = cvtpk(p[s][8 * k + 2 * j], p[s][8 * k + 2 * j + 1]);
    }
}
template <int NS>
__device__ __forceinline__ void attn_pv(AttnState<NS>& S, const unsigned (&pb)[NS][2][4], LAS const unsigned char* vimg, int lane) {
    const int hi = lane >> 5, qq = (lane & 15) >> 2, pp = lane & 3, g1 = (lane >> 4) & 1;
    LAS const unsigned char* vrow = vimg + (4 * hi + qq) * 256 + (2 * g1 + (pp >> 1)) * 16 + (pp & 1) * 8;
#pragma unroll
    for (int d = 0; d < 4; ++d) { LAS const unsigned char* vb = vrow + ((d ^ qq) << 6);
#pragma unroll
        for (int k = 0; k < 2; ++k) {
            const s16x4 lo = ds_tr16(vb + (16 * k) * 256), hh = ds_tr16(vb + (16 * k + 8) * 256);
            const bf16x8 vf = {lo[0], lo[1], lo[2], lo[3], hh[0], hh[1], hh[2], hh[3]};
#pragma unroll
            for (int s = 0; s < NS; ++s) { const v4u w = {pb[s][k][0], pb[s][k][1], pb[s][k][2], pb[s][k][3]}; S.o[s][d] = MFMA32(vf, __builtin_bit_cast(bf16x8, w), S.o[s][d]); } } }
}
struct NoHook { __device__ __forceinline__ void operator()() const {} };
struct RefillK { LAS unsigned char* kbuf; const bf16* base; int colK; RowMap nrm; const LaneOff* lo; bool on;
    __device__ __forceinline__ void operator()() const { if (on) glds_tile<false>(kbuf, base, colK, nrm, *lo); } };
template <int NS>
__device__ __forceinline__ void attn_subtile(AttnState<NS>& S, const bf16x8 (&qf)[8], LAS unsigned char* kbuf, LAS unsigned char* vbuf, const bf16* base, int colK, int colV, const RowMap nrm, bool has_next,
                                             LAS const float* tab, int jlo, int jhi, float c1, int lane, const LaneOff& lo) {
    AT_WAITV(8);
    f32x16 p[NS]; unsigned pb[NS][2][4];
    attn_scores<NS>(p, qf, kbuf, lane, RefillK{kbuf, base, colK, nrm, &lo, has_next});
    attn_softmax<NS>(S, p, pb, tab, jlo, jhi, c1);
    if (has_next) AT_WAITV(8); else AT_WAITV(0);
    attn_pv<NS>(S, pb, vbuf, lane);
    AT_WAITL(); __builtin_amdgcn_sched_barrier(0);
    if (has_next) glds_tile<true>(vbuf, base, colV, nrm, lo);
}
template <int NS> __device__ __forceinline__ void attn_init(AttnState<NS>& S) {
#pragma unroll
    for (int s = 0; s < NS; ++s) { S.m[s] = AT_MINIT; S.l[s] = 0.f;
#pragma unroll
        for (int d = 0; d < 4; ++d) S.o[s][d] = (f32x16){0.f, 0.f, 0.f, 0.f, 0.f, 0.f, 0.f, 0.f, 0.f, 0.f, 0.f, 0.f, 0.f, 0.f, 0.f, 0.f}; }
}
__device__ __forceinline__ void load_qfrags(bf16x8 (&qf)[8], LAS unsigned char* kbuf, const bf16* base, int col, const RowMap rm, int lane, const LaneOff& lo) {
    glds_tile<false>(kbuf, base, col, rm, lo);
    AT_WAITV(0);
#pragma unroll
    for (int c = 0; c < 8; ++c) qf[c] = kimg_frag(kbuf, c, lane);
    AT_WAITL(); __builtin_amdgcn_sched_barrier(0);
}

constexpr int MX_STG = 0;
constexpr int MX_TABA = 8 * AT_WAVE;
constexpr int TABA_N = 2048 + 2 * AT_PAD + 1;
constexpr int MX_ITEM = 163840 - 64;
static_assert(MX_TABA + TABA_N * 4 <= MX_ITEM, "mixer A LDS map");

constexpr int AR_SLOT = 2 * AT_BUF, AR_NSLOT = 4, AR_AHEAD = 3;
static_assert(AR_NSLOT * AR_SLOT <= MX_TABA, "ring below the bias table");
__device__ __forceinline__ void ring_issue(LAS unsigned char* ring, int t, const bf16* base, int colK, int colV, int wave, unsigned kof, unsigned vof) {
    LAS unsigned char* slot = ring + (t & (AR_NSLOT - 1)) * AR_SLOT;
    const unsigned la = (unsigned)__builtin_amdgcn_readfirstlane((int)(unsigned)(uintptr_t)slot) + (unsigned)wave * 1024u;
    const size_t rowoff = ((size_t)(32 * t) + (size_t)(4 * (wave & 3) + 16 * (wave >> 2))) * 128;
    const unsigned long long k64 = (unsigned long long)(uintptr_t)(base + (size_t)colK * (MROWS * 128) + rowoff), v64 = (unsigned long long)(uintptr_t)(base + (size_t)colV * (MROWS * 128) + rowoff);
    const GAS char* kb = (const GAS char*)(uintptr_t)(((unsigned long long)(unsigned)__builtin_amdgcn_readfirstlane((int)(k64 >> 32)) << 32) | (unsigned)__builtin_amdgcn_readfirstlane((int)k64));
    const GAS char* vb = (const GAS char*)(uintptr_t)(((unsigned long long)(unsigned)__builtin_amdgcn_readfirstlane((int)(v64 >> 32)) << 32) | (unsigned)__builtin_amdgcn_readfirstlane((int)v64));
    glds16(kb, kof, la); glds16(vb, vof, la + AT_BUF);
}
__device__ __forceinline__ void mixer_a_block(Frame& F, int layer, int b, int h, int qb, int wave, int lane) {
    LAS unsigned char* ring = F.lds + MX_STG;
    LAS const float* tab = (LAS const float*)(F.lds + MX_TABA);
    const bf16* base = F.proj + (size_t)(b * SEQ) * 128;
    const int q0 = qb * 256 + wave * 32, colK = C_AK / 128 + h, colV = C_AV / 128 + h;
    const LaneOff lo = lane_off(1, lane);
    bf16x8 qf[8];
    load_qfrags(qf, ring + wave * AT_BUF, base, C_AQ / 128 + h, RowMap{q0, 1, 16}, lane, lo);
    const unsigned kof = (unsigned)((lane >> 4) * 128 + (((lane & 15) ^ (4 * (wave & 3) + (lane >> 4))) * 8)) * 2u, vof = lo.v;
    __builtin_amdgcn_s_barrier();
    AttnState<2> S; attn_init<2>(S);
    const int nt = qb * 8 + 8, mydiag = qb * 8 + wave;
    const int hi = lane >> 5, ql = lane & 31;
    int jb = AT_PAD + 2047 - q0 - ql + 4 * hi;
#pragma unroll
    for (int t = 0; t < AR_AHEAD; ++t) ring_issue(ring, t, base, colK, colV, wave, kof, vof);
#pragma unroll 1
    for (int u = 0; u < nt; ++u, jb += 32) {
        const int left = nt - 1 - u;
        if (left >= 2) AT_WAITV(4); else if (left == 1) AT_WAITV(2); else AT_WAITV(0);
        AT_WAITL(); __builtin_amdgcn_s_barrier();
        if (u + AR_AHEAD < nt) ring_issue(ring, u + AR_AHEAD, base, colK, colV, wave, kof, vof);
        if (u <= mydiag) {
            LAS const unsigned char* slot = ring + (u & (AR_NSLOT - 1)) * AR_SLOT;
            f32x16 p[2]; unsigned pb[2][2][4];
            attn_scores<2>(p, qf, slot, lane, NoHook{});
            attn_softmax<2>(S, p, pb, tab, jb, jb, 0.125f * LOG2E);
            attn_pv<2>(S, pb, slot + AT_BUF, lane);
        }
    }
    AT_WAITL(); __builtin_amdgcn_s_barrier();
    const float lam = F.lamv[layer], li = lam_init_of(layer);
    const float l0 = xor32_sum(S.l[0]), l1 = xor32_sum(S.l[1]);
    const float i0 = 1.f / l0, i1 = lam / l1;
    float ss = 0.f;
#pragma unroll
    for (int d = 0; d < 4; ++d)
#pragma unroll
        for (int r = 0; r < 16; ++r) { const float v = S.o[0][d][r] * i0 - S.o[1][d][r] * i1; S.o[0][d][r] = v; ss += v * v; }
    ss = xor32_sum(ss);
    const float rn = rsqrtf(ss * (1.f / 128.f) + LN_EPS) * (1.f - li);
    const size_t row = (size_t)(b * SEQ + q0 + ql);
    const bf16* gp = F.proj + ((size_t)(C_AG / 128 + h) * MROWS + row) * 128 + 4 * hi;
    bf16* op = F.ymix + row * DM + Y_A + h * 128 + 4 * hi;
    const float* gn = F.head_gain + layer * 128 + 4 * hi;
#pragma unroll
    for (int d = 0; d < 4; ++d)
#pragma unroll
        for (int g = 0; g < 4; ++g) {
            const int dd = 32 * d + 8 * g;
            const v2u ag = *(const GAS v2u*)(gp + dd); const f32x4 gv = *(const GAS f32x4*)(gn + dd);
            v2u o; o.x = pk2(S.o[0][d][4 * g] * rn * gv.x * silu_f(bflo(ag.x)), S.o[0][d][4 * g + 1] * rn * gv.y * silu_f(bfhi(ag.x)));
            o.y = pk2(S.o[0][d][4 * g + 2] * rn * gv.z * silu_f(bflo(ag.y)), S.o[0][d][4 * g + 3] * rn * gv.w * silu_f(bfhi(ag.y)));
            *(GAS v2u*)(op + dd) = o;
        }
    AT_WAITV(0);
}
__device__ __forceinline__ void mixer_a_item(Frame& F, int layer, int item, int tid_, int wave_, int lane_) {
    int wave = wave_, lane = lane_id_v(); asm volatile("" : "+s"(wave)); const int tid = wave * 64 + lane; (void)tid_; (void)lane_;
    const int pr = item & 3, bh = item >> 2, h = bh & 3, b = bh >> 2;
    LAS float* tab = (LAS float*)(F.lds + MX_TABA);
    for (int j = tid; j < TABA_N; j += NWAVES * 64) { const int rel = 2047 + AT_PAD - j; tab[j] = (rel >= 0 && rel <= 2047) ? F.biasA[h * 2048 + rel] * LOG2E : AT_MASK; }
    AT_WAITV(0);
    __syncthreads();
    mixer_a_block(F, layer, b, h, 7 - pr, wave, lane);
    mixer_a_block(F, layer, b, h, pr, wave, lane);
    __syncthreads();
}

constexpr int MX_TABB = 8 * AT_WAVE, TABB_N = 200;
static_assert(MX_TABB + 3 * TABB_N * 4 <= MX_ITEM, "mixer B LDS map");
constexpr size_t BST_ROW = 128 * 4 + 16, BST_BYTES = 256 * BST_ROW;

__device__ __forceinline__ void b_state_save(unsigned char* st, const AttnState<1>& S, int tau, int lane) {
    const int hi = lane >> 5;
    float* row = (float*)(st + (size_t)tau * BST_ROW) + 4 * hi;
#pragma unroll
    for (int d = 0; d < 4; ++d)
#pragma unroll
        for (int g = 0; g < 4; ++g) *(GAS f32x4*)(row + 32 * d + 8 * g) = (f32x4){S.o[0][d][4 * g], S.o[0][d][4 * g + 1], S.o[0][d][4 * g + 2], S.o[0][d][4 * g + 3]};
    const float lt = xor32_sum(S.l[0]);
    if (hi == 0) { f32x2 ml = {S.m[0], lt}; *(GAS f32x2*)((float*)(st + (size_t)tau * BST_ROW) + 128) = ml; }
}
__device__ __forceinline__ void b_state_load(const unsigned char* st, AttnState<1>& S, int tau, int lane) {
    const int hi = lane >> 5;
    const float* row = (const float*)(st + (size_t)tau * BST_ROW) + 4 * hi;
#pragma unroll
    for (int d = 0; d < 4; ++d)
#pragma unroll
        for (int g = 0; g < 4; ++g) { const f32x4 w = *(const GAS f32x4*)(row + 32 * d + 8 * g);
            S.o[0][d][4 * g] = w.x; S.o[0][d][4 * g + 1] = w.y; S.o[0][d][4 * g + 2] = w.z; S.o[0][d][4 * g + 3] = w.w; }
    const f32x2 ml = *(const GAS f32x2*)((const float*)(st + (size_t)tau * BST_ROW) + 128);
    S.m[0] = ml.x; S.l[0] = hi == 0 ? ml.y : 0.f;
}

__device__ __forceinline__ void mixer_b_item(Frame& F, int layer, int item, int tid_, int wave_, int lane_) {
    int wave = wave_, lane = lane_id_v(); asm volatile("" : "+s"(wave)); const int tid = wave * 64 + lane; (void)tid_; (void)lane_;
    const int blk = item & 7, bh = item >> 3, h = bh & 7, b = bh >> 3, T0 = blk * 256;
    LAS float* tabs = (LAS float*)(F.lds + MX_TABB);
    for (int j = tid; j < 3 * TABB_N; j += NWAVES * 64) { const int p = j / TABB_N, jj = j - p * TABB_N, rel = 128 + AT_PAD - jj;
        tabs[j] = (rel >= 0 && rel <= 128) ? F.biasB[(p * 8 + h) * 132 + rel] * LOG2E : AT_MASK; }
    AT_WAITV(0);
    __syncthreads();
    LAS unsigned char* kbuf = F.lds + MX_STG + wave * AT_WAVE; LAS unsigned char* vbuf = kbuf + AT_BUF;
    unsigned char* st = F.bstate + (size_t)blockIdx.x * BST_BYTES;
    const bf16* base = F.proj + (size_t)(b * SEQ) * 128;
    const int colQ = C_BQ / 128 + h, colK = C_BK / 128 + h, colV = C_BV / 128 + h;
    const float c1 = 0.08838834764831845f * LOG2E;
    const int hi = lane >> 5, ql = lane & 31;
    AttnState<1> S; bf16x8 qf[8];
    { attn_init<1>(S);
      const LaneOff lo = lane_off(1, lane);
      load_qfrags(qf, kbuf, base, colQ, RowMap{T0 + 32 * wave, 1, 16}, lane, lo);
      const int k0 = T0 + 32 * wave - 128; const int u0 = k0 < 0 ? (-k0) >> 5 : 0;
      glds_tile<false>(kbuf, base, colK, RowMap{k0 + 32 * u0, 1, 16}, lo); glds_tile<true>(vbuf, base, colV, RowMap{k0 + 32 * u0, 1, 16}, lo);
#pragma unroll 1
      for (int u = u0; u < 5; ++u) { const int jb = AT_PAD - ql + 32 * u + 4 * hi;
          attn_subtile<1>(S, qf, kbuf, vbuf, base, colK, colV, RowMap{k0 + 32 * (u + 1), 1, 16}, u + 1 < 5, tabs, jb, jb, c1, lane, lo); }
      b_state_save(st, S, 32 * wave + ql, lane); }
    AT_WAITV(0); __syncthreads();
    { const int r = wave & 3, c = wave >> 2, tau = 128 * c + 4 * ql + r;
      b_state_load(st, S, tau, lane);
      AT_WAITV(0); asm volatile("" ::: "memory");
      const LaneOff lo = lane_off(4, lane);
      load_qfrags(qf, kbuf, base, colQ, RowMap{T0 + 128 * c + r, 4, 64}, lane, lo);
      const int l0 = T0 / 4 + 32 * c - 128; const int u0 = l0 < 0 ? (-l0) >> 5 : 0;
      glds_tile<false>(kbuf, base, colK, RowMap{4 * (l0 + 32 * u0) + r, 4, 64}, lo); glds_tile<true>(vbuf, base, colV, RowMap{4 * (l0 + 32 * u0) + r, 4, 64}, lo);
#pragma unroll 1
      for (int u = u0; u < 5; ++u) { const int jb = AT_PAD - ql + 32 * u + 4 * hi;
          attn_subtile<1>(S, qf, kbuf, vbuf, base, colK, colV, RowMap{4 * (l0 + 32 * (u + 1)) + r, 4, 64}, u + 1 < 5, tabs + TABB_N, jb, jb, c1, lane, lo); }
      b_state_save(st, S, tau, lane); }
    AT_WAITV(0); __syncthreads();
    { const int tau = 16 * (ql & 15) + 2 * wave + (ql >> 4);
      b_state_load(st, S, tau, lane);
      AT_WAITV(0); asm volatile("" ::: "memory");
      const LaneOff lo = lane_off(16, lane);
      load_qfrags(qf, kbuf, base, colQ, RowMap{T0 + 2 * wave, 16, 1}, lane, lo);
      const int x0 = T0 / 16 - 128; const int v0 = x0 < 0 ? (-x0) >> 4 : 0;
      glds_tile<false>(kbuf, base, colK, RowMap{16 * (x0 + 16 * v0) + 2 * wave, 16, 1}, lo); glds_tile<true>(vbuf, base, colV, RowMap{16 * (x0 + 16 * v0) + 2 * wave, 16, 1}, lo);
#pragma unroll 1
      for (int v = v0; v < 9; ++v) { const int jv = AT_PAD + 16 * v - ql + 4 * hi;
          attn_subtile<1>(S, qf, kbuf, vbuf, base, colK, colV, RowMap{16 * (x0 + 16 * (v + 1)) + 2 * wave, 16, 1}, v + 1 < 9, tabs + 2 * TABB_N, (ql < 16) ? jv : 0, (ql < 16) ? 0 : jv, c1, lane, lo); }
      const float lt = xor32_sum(S.l[0]), il = 1.f / lt;
      const size_t row = (size_t)(b * SEQ + T0 + tau);
      const bf16* gp = F.proj + ((size_t)(C_BG / 128 + h) * MROWS + row) * 128 + 4 * hi;
      bf16* op = F.ymix + row * DM + Y_B + h * 128 + 4 * hi;
#pragma unroll
      for (int d = 0; d < 4; ++d)
#pragma unroll
          for (int g = 0; g < 4; ++g) { const int dd = 32 * d + 8 * g; const v2u bg = *(const GAS v2u*)(gp + dd);
              v2u o; o.x = pk2(S.o[0][d][4 * g] * il * silu_f(bflo(bg.x)), S.o[0][d][4 * g + 1] * il * silu_f(bfhi(bg.x)));
              o.y = pk2(S.o[0][d][4 * g + 2] * il * silu_f(bflo(bg.y)), S.o[0][d][4 * g + 3] * il * silu_f(bfhi(bg.y)));
              *(GAS v2u*)(op + dd) = o; } }
    AT_WAITV(0); __syncthreads();
}

constexpr int MC_AIMG = 0, MC_ACH = 64 * 16 + 16;
constexpr int MC_PART = 64 * MC_ACH;
constexpr int MC_STAT = MC_PART + 2 * 64 * 64 * 4;
static_assert(MC_STAT + 512 <= MX_ITEM, "mixer C LDS map");

template <int I0> __device__ __forceinline__ void conv_group(f32x2 (&acc)[32], const f32x2 (&w)[CONVW], const bf16* base, int tb, int c0) {
    f32x2 g[8];
#pragma unroll
    for (int ii = 0; ii < 8; ++ii) { const int i = I0 + ii; if (i < 32 + CONVW - 1) {
        const int tk = tb + i, tc = tk < 0 ? 0 : tk;
        const unsigned u = *(const GAS unsigned*)(base + (size_t)tc * 128), gl = *(const GAS unsigned*)(base + (size_t)(C_CGLU - C_CU) / 128 * (MROWS * 128) + (size_t)tc * 128);
        g[ii].x = bflo(u) * sigmoid_f(bflo(gl)); g[ii].y = bfhi(u) * sigmoid_f(bfhi(gl));
        if (tk < 0) { g[ii].x = 0.f; g[ii].y = 0.f; } } }
#pragma unroll
    for (int ii = 0; ii < 8; ++ii)
#pragma unroll
        for (int j = 0; j < CONVW; ++j) { const int i = I0 + ii, o = i - j; if (i < 32 + CONVW - 1 && o >= 0 && o < 32) acc[o] = w[j] * g[ii] + acc[o]; }
    asm volatile("" ::: "memory");
}

__device__ __forceinline__ void mixer_c_item(Frame& F, int layer, int item, int tid_, int wave_, int lane_) {
    int wave = wave_, lane = lane_id_v(); asm volatile("" : "+s"(wave)); const int tid = wave * 64 + lane; (void)tid_; (void)lane_;
    const int b = item >> 5, t0 = (item & 31) * 64;
    const int cp = tid & 255, th = tid >> 8, c0 = 2 * cp;
    const bf16* base = F.proj + ((size_t)(C_CU / 128 + (c0 >> 7)) * MROWS + b * SEQ) * 128 + (c0 & 127);
    f32x2 acc[32];
    {
        f32x2 w[CONVW];
        const float* dw = F.conv_dw + (size_t)layer * CONVW * DC + c0;
#pragma unroll
        for (int j = 0; j < CONVW; ++j) w[j] = *(const GAS f32x2*)(dw + j * DC);
        const f32x2 cb = *(const GAS f32x2*)(F.conv_b + layer * DC + c0);
#pragma unroll
        for (int o = 0; o < 32; ++o) acc[o] = cb;
        const int tb = t0 + 32 * th - (CONVW - 1);
        conv_group<0>(acc, w, base, tb, c0); conv_group<8>(acc, w, base, tb, c0); conv_group<16>(acc, w, base, tb, c0); conv_group<24>(acc, w, base, tb, c0);
        conv_group<32>(acc, w, base, tb, c0); conv_group<40>(acc, w, base, tb, c0); conv_group<48>(acc, w, base, tb, c0); conv_group<56>(acc, w, base, tb, c0);
    }
    { LAS float* part = (LAS float*)(F.lds + MC_PART);
#pragma unroll
      for (int o = 0; o < 32; ++o) { float s1 = acc[o].x + acc[o].y, s2 = acc[o].x * acc[o].x + acc[o].y * acc[o].y;
          s1 = quad_sum(s1); s2 = quad_sum(s2);
          if ((lane & 3) == 0) { part[(32 * th + o) * 64 + (cp >> 2)] = s1; part[4096 + (32 * th + o) * 64 + (cp >> 2)] = s2; } } }
    __syncthreads();
    { LAS const float* part = (LAS const float*)(F.lds + MC_PART); LAS float* stat = (LAS float*)(F.lds + MC_STAT);
      const int tok = tid >> 3, k = tid & 7;
      const f32x4 a0 = *(LAS const f32x4*)(part + tok * 64 + 8 * k), a1 = *(LAS const f32x4*)(part + tok * 64 + 8 * k + 4);
      const f32x4 b0 = *(LAS const f32x4*)(part + 4096 + tok * 64 + 8 * k), b1 = *(LAS const f32x4*)(part + 4096 + tok * 64 + 8 * k + 4);
      float s1 = (a0.x + a0.y) + (a0.z + a0.w) + (a1.x + a1.y) + (a1.z + a1.w), s2 = (b0.x + b0.y) + (b0.z + b0.w) + (b1.x + b1.y) + (b1.z + b1.w);
      s1 = oct_sum(s1); s2 = oct_sum(s2);
      const float mean = s1 * (1.f / DC), var = fmaxf(s2 * (1.f / DC) - mean * mean, 0.f);
      if (k == 0) { stat[2 * tok] = mean; stat[2 * tok + 1] = rsqrtf(var + LN_EPS); } }
    __syncthreads();
    { LAS const f32x2* stat = (LAS const f32x2*)(F.lds + MC_STAT);
      const f32x2 lg = *(const GAS f32x2*)(F.conv_ln_g + layer * DC + c0), lb = *(const GAS f32x2*)(F.conv_ln_b + layer * DC + c0);
      LAS unsigned char* ap = F.lds + MC_AIMG + (cp >> 2) * MC_ACH + (32 * th) * 16 + (cp & 3) * 4;
#pragma unroll
      for (int o = 0; o < 32; ++o) { const f32x2 st = stat[32 * th + o];
          const float h0 = (acc[o].x - st.x) * st.y * lg.x + lb.x, h1 = (acc[o].y - st.x) * st.y * lg.y + lb.y;
          *(LAS unsigned*)(ap + o * 16) = cvtpk(silu_f(h0), silu_f(h1)); } }
    __syncthreads();
    f32x16 pa[2][2];
#pragma unroll
    for (int nt = 0; nt < 2; ++nt)
#pragma unroll
        for (int tt = 0; tt < 2; ++tt) pa[nt][tt] = (f32x16){0.f, 0.f, 0.f, 0.f, 0.f, 0.f, 0.f, 0.f, 0.f, 0.f, 0.f, 0.f, 0.f, 0.f, 0.f, 0.f};
    { const int hi = lane >> 5, ql = lane & 31;
      const bf16* wp = F.wpw_t + (size_t)layer * DC * DC + (size_t)(64 * wave + ql) * DC + 8 * hi;
      LAS const unsigned char* ab = F.lds + MC_AIMG + hi * MC_ACH + ql * 16;
#pragma unroll 4
      for (int c = 0; c < 32; ++c) {
          const bf16x8 w0 = *(const GAS bf16x8*)(wp + 16 * c), w1 = *(const GAS bf16x8*)(wp + 32 * DC + 16 * c);
          const bf16x8 x0 = *(LAS const bf16x8*)(ab + c * 2 * MC_ACH), x1 = *(LAS const bf16x8*)(ab + c * 2 * MC_ACH + 512);
          pa[0][0] = MFMA32(w0, x0, pa[0][0]); pa[0][1] = MFMA32(w0, x1, pa[0][1]); pa[1][0] = MFMA32(w1, x0, pa[1][0]); pa[1][1] = MFMA32(w1, x1, pa[1][1]); }
#pragma unroll
      for (int tt = 0; tt < 2; ++tt) { const size_t row = (size_t)(b * SEQ + t0 + 32 * tt + ql);
          const bf16* gp = F.proj + ((size_t)(C_CG / 128 + (wave >> 1)) * MROWS + row) * 128 + 64 * (wave & 1) + 4 * hi; bf16* op = F.ymix + row * DM + Y_C + 64 * wave + 4 * hi;
#pragma unroll
          for (int nt = 0; nt < 2; ++nt)
#pragma unroll
              for (int g = 0; g < 4; ++g) { const int nn = 32 * nt + 8 * g; const v2u cg = *(const GAS v2u*)(gp + nn);
                  v2u o; o.x = pk2(pa[nt][tt][4 * g] * silu_f(bflo(cg.x)), pa[nt][tt][4 * g + 1] * silu_f(bfhi(cg.x)));
                  o.y = pk2(pa[nt][tt][4 * g + 2] * silu_f(bflo(cg.y)), pa[nt][tt][4 * g + 3] * silu_f(bfhi(cg.y)));
                  *(GAS v2u*)(op + nn) = o; } } }
    __syncthreads();
}
struct Args { const float* in[13]; float* out; unsigned char* ws; int ph_lo, ph_hi; };
constexpr int N_PHASES = 1 + 4 * DEPTH;
constexpr int CW_BAR = 4096;
static_assert((CW_BAR + XCD_BAR_WORDS) * 4 <= (int)CTL_ZERO_BYTES, "control words inside the memset region");
#ifndef REP_PRO
#define REP_PRO 1
#endif
#ifndef REP_G1
#define REP_G1 1
#endif
#ifndef REP_MIX
#define REP_MIX 1
#endif
#ifndef REP_G2
#define REP_G2 1
#endif
#ifndef REP_LN
#define REP_LN 1
#endif
#ifndef MK_ONE_LAUNCH
#define MK_ONE_LAUNCH 1
#endif

constexpr int N_ITEMS_A = 128, N_ITEMS_B = 512, N_ITEMS_C = 256;
#ifndef REP_A
#define REP_A 1
#endif
#ifndef REP_B
#define REP_B 1
#endif
#ifndef REP_C
#define REP_C 1
#endif
__device__ __forceinline__ void mixer_phase(Frame& F, int layer, int cidx) {
    PHASE_IDS();
    constexpr int LA = 16 * REP_A, LB = 64 * REP_B, LC = 32 * REP_C, LT = LA + LB + LC;
    const int x0 = (int)xb_xcc_id() & 7;
    for (int dx = 0; dx < 8; ++dx) {
        const int x = (x0 + dx) & 7;
        unsigned* ctr = F.ctl + 64 * (cidx * 8 + x);
        for (;;) {
            int ioff = MX_ITEM; asm volatile("" : "+s"(ioff));
            volatile LAS unsigned* itemw = (volatile LAS unsigned*)(F.lds + ioff);
            if (wave == 0 && lane_id_v() == 0) *itemw = __hip_atomic_fetch_add(ctr, 1u, __ATOMIC_RELAXED, __HIP_MEMORY_SCOPE_AGENT);
            __syncthreads();
            const int li = __builtin_amdgcn_readfirstlane((int)*itemw);
            __syncthreads();
            if (li >= LT) break;
            if (li < LA) { const int i = li % 16; mixer_a_item(F, layer, (x + 8 * (i >> 2)) * 4 + (i & 3), tid, wave, lane); }
            else if (li < LA + LB) { const int i = (li - LA) % 64; mixer_b_item(F, layer, (x + 8 * (i >> 3)) * 8 + (i & 7), tid, wave, lane); }
            else { const int i = (li - LA - LB) % 32; mixer_c_item(F, layer, x * 32 + i, tid, wave, lane); }
        }
    }
    __syncthreads();
}

__global__ void __launch_bounds__(NWAVES * 64, 2) hymba_fwd(Args args) {
    extern __shared__ __attribute__((aligned(16))) unsigned char lds[];
    Frame F;
    F.lds = (LAS unsigned char*)lds;
    F.G = gridDim.x; F.wave = __builtin_amdgcn_readfirstlane(threadIdx.x >> 6);
    unsigned char* ws = args.ws;
    F.x = args.in[0]; F.w_in = args.in[1]; F.diff_lambda = args.in[2]; F.head_gain = args.in[3]; F.conv_dw = args.in[4]; F.conv_b = args.in[5];
    F.conv_ln_g = args.in[6]; F.conv_ln_b = args.in[7]; F.conv_pw = args.in[8]; F.w_out = args.in[9]; F.ln_g = args.in[10]; F.ln_b = args.in[11]; F.rel_bias = args.in[12];
    F.out = args.out;
    F.win_t = (bf16*)(ws + WS_WIN); F.wout_t = (bf16*)(ws + WS_WOUT); F.wpw_t = (bf16*)(ws + WS_WPW); F.xb = (bf16*)(ws + WS_XB); F.ymix = (bf16*)(ws + WS_Y); F.proj = (bf16*)(ws + WS_PROJ);
    F.biasA = (float*)(ws + WS_TAB + TAB_BIASA); F.biasB = (float*)(ws + WS_TAB + TAB_BIASB); F.lamv = (float*)(ws + WS_TAB + TAB_LAM); F.ctl = (unsigned*)(ws + WS_CTL); F.bstate = ws + WS_BST;
    const int lo = args.ph_lo, hi = args.ph_hi;
#define IN(k) (lo <= (k) && (k) < hi)
#if MK_ONE_LAUNCH
    const bool t0 = (F.wave == 0) && (lane_id_v() == 0);
    { volatile LAS unsigned* stw = (volatile LAS unsigned*)(F.lds + MX_ITEM + 16); if (t0) { stw[0] = 0u; stw[1] = 0u; } }
    __syncthreads();
    const XcdBarrier bar = xcd_barrier_post(F.ctl + CW_BAR, (volatile LAS unsigned*)(F.lds + MX_ITEM + 16), t0);
#define GRID_BAR() xcd_barrier(bar, (F.wave == 0) && (lane_id_v() == 0))
#else
#define GRID_BAR() do {} while (0)
#endif
    if (IN(0)) { for (int rep = 0; rep < REP_PRO; ++rep) p0_prologue(F); if (IN(1)) GRID_BAR(); }
#define LAYER_ID 0
    { constexpr int layer = LAYER_ID; const int p = 1 + 4 * layer;
        if (IN(p)) {
            pg8::Gemm g{F.xb, F.win_t + (size_t)layer * DIN * DM, MROWS, DIN, DM}; pg8::StaticOrder S; S.init(MROWS, DIN, F.G, (int)blockIdx.x);
            EpiHeadMajor E{F.proj};
            for (int rep = 0; rep < REP_G1; ++rep) pg8::gemm_phase<EpiHeadMajor, pg8::StaticOrder, true, true>(F.lds, g, S, E, F.wave);
            if (IN(p + 1)) GRID_BAR();
        }
        if (IN(p + 1)) {
            for (int rep = 0; rep < REP_MIX; ++rep) mixer_phase(F, layer, layer + 2 * rep);
            if (IN(p + 2)) GRID_BAR();
        }
        if (IN(p + 2)) {
            pg8::Gemm g{F.ymix, F.wout_t + (size_t)layer * DM * DM, MROWS, DM, DM}; pg8::StaticOrder S; S.init(MROWS, DM, F.G, (int)blockIdx.x);
            EpiResid E{layer == 0 ? F.x : F.out, F.out, DM, ALPHA};
            for (int rep = 0; rep < REP_G2; ++rep) pg8::gemm_phase<EpiResid, pg8::StaticOrder, true, true>(F.lds, g, S, E, F.wave);
            if (IN(p + 3)) GRID_BAR();
        }
        if (IN(p + 3)) {
            for (int rep = 0; rep < REP_LN; ++rep) ln_phase(F, layer, layer + 1 < DEPTH);
            if (IN(p + 4)) GRID_BAR();
        }
    }
#undef LAYER_ID
#define LAYER_ID 1
    { constexpr int layer = LAYER_ID; const int p = 1 + 4 * layer;
        if (IN(p)) {
            pg8::Gemm g{F.xb, F.win_t + (size_t)layer * DIN * DM, MROWS, DIN, DM}; pg8::StaticOrder S; S.init(MROWS, DIN, F.G, (int)blockIdx.x);
            EpiHeadMajor E{F.proj};
            for (int rep = 0; rep < REP_G1; ++rep) pg8::gemm_phase<EpiHeadMajor, pg8::StaticOrder, true, true>(F.lds, g, S, E, F.wave);
            if (IN(p + 1)) GRID_BAR();
        }
        if (IN(p + 1)) {
            for (int rep = 0; rep < REP_MIX; ++rep) mixer_phase(F, layer, layer + 2 * rep);
            if (IN(p + 2)) GRID_BAR();
        }
        if (IN(p + 2)) {
            pg8::Gemm g{F.ymix, F.wout_t + (size_t)layer * DM * DM, MROWS, DM, DM}; pg8::StaticOrder S; S.init(MROWS, DM, F.G, (int)blockIdx.x);
            EpiResid E{layer == 0 ? F.x : F.out, F.out, DM, ALPHA};
            for (int rep = 0; rep < REP_G2; ++rep) pg8::gemm_phase<EpiResid, pg8::StaticOrder, true, true>(F.lds, g, S, E, F.wave);
            if (IN(p + 3)) GRID_BAR();
        }
        if (IN(p + 3)) {
            for (int rep = 0; rep < REP_LN; ++rep) ln_phase(F, layer, layer + 1 < DEPTH);
            if (IN(p + 4)) GRID_BAR();
        }
    }
#undef LAYER_ID
#undef IN
}

extern "C" void kernel_launch(void* const* d_in, const int* in_sizes, int n_in, void* d_out, int out_size, void* d_ws, size_t ws_size, hipStream_t stream) {
    static int grid = 0;
    if (grid == 0) {
        if (n_in != 13 || in_sizes[0] != MROWS * DM || out_size != MROWS * DM || ws_size < WS_END) { fprintf(stderr, "kernel_launch: unexpected shapes (n_in %d, in0 %d, out %d, ws %zu)\n", n_in, n_in > 0 ? in_sizes[0] : -1, out_size, ws_size); grid = -1; return; }
        int dev = 0, cus = 0, per_cu = 0;
        if (hipGetDevice(&dev) != hipSuccess || hipDeviceGetAttribute(&cus, hipDeviceAttributeMultiprocessorCount, dev) != hipSuccess) { grid = -1; return; }
        if (hipFuncSetAttribute((const void*)hymba_fwd, hipFuncAttributeMaxDynamicSharedMemorySize, LDS_BYTES) != hipSuccess) { fprintf(stderr, "kernel_launch: hipFuncSetAttribute failed\n"); grid = -1; return; }
        if (hipOccupancyMaxActiveBlocksPerMultiprocessor(&per_cu, (const void*)hymba_fwd, NWAVES * 64, LDS_BYTES) != hipSuccess || per_cu < 1) { fprintf(stderr, "kernel_launch: occupancy query says %d\n", per_cu); per_cu = 1; }
        (void)hipGetLastError();
        grid = cus;
    }
    if (grid < 0) return;
    if (hipMemsetAsync((char*)d_ws + WS_CTL, 0, CTL_ZERO_BYTES, stream) != hipSuccess) { fprintf(stderr, "kernel_launch: memset failed\n"); return; }
    Args a{};
    for (int i = 0; i < 13; ++i) a.in[i] = (const float*)d_in[i];
    a.out = (float*)d_out; a.ws = (unsigned char*)d_ws;
#if MK_ONE_LAUNCH
    a.ph_lo = 0; a.ph_hi = N_PHASES;
    hipLaunchKernelGGL(hymba_fwd, dim3(grid), dim3(NWAVES * 64), LDS_BYTES, stream, a);
    const hipError_t e = hipPeekAtLastError();
    if (e != hipSuccess) fprintf(stderr, "kernel_launch: launch failed: %s (grid %d)\n", hipGetErrorString(e), grid);
#else
    for (int ph = 0; ph < N_PHASES; ++ph) {
        a.ph_lo = ph; a.ph_hi = ph + 1;
        hipLaunchKernelGGL(hymba_fwd, dim3(grid), dim3(NWAVES * 64), LDS_BYTES, stream, a);
        const hipError_t le = hipPeekAtLastError();
        if (le != hipSuccess) { fprintf(stderr, "kernel_launch: launch %d failed: %s\n", ph, hipGetErrorName(le)); break; }
    }
#endif
}
```
